# Optimizing an MI355X kernel written in HIP

```python
import math
import jax, jax.numpy as jnp
from jax import lax
import numpy as np

D_MODEL = 1024
BATCH = 16
SEQ = 256
DEPTH = 1
DEC_BATCH = 8
DEC_SEQ = 1024
PAST_LEN = 256

GRID_W = 64
MIX_W = D_MODEL
N_DIR = 2
SSD_W = MIX_W // 2
SSD_HEAD_DIM = 64
SSD_HEADS = SSD_W // SSD_HEAD_DIM
SSD_GROUPS = 2
SSD_STATE = 64
SSD_CHUNK = 128
SSD_CONV = 3
SSD_XBC = SSD_W + 2 * SSD_GROUPS * SSD_STATE
HY_W = MIX_W - SSD_W
HY_ORDER = 2
HY_CONV = 3
HY_EMB = 33
HY_BANDS = (HY_EMB - 1) // 2
HY_FILTER_HIDDEN = 64
HY_DECAY_TARGET = 1e-2
HY_FAST_PCT = 0.3
HY_SLOW_PCT = 1.5
HY_MIN_DECAY = math.log(HY_DECAY_TARGET) / HY_SLOW_PCT
HY_MAX_DECAY = math.log(HY_DECAY_TARGET) / HY_FAST_PCT
FFN_DIM = 2752
N_MOD = 9
RMS_EPS = 1e-6
IN_COLS = SSD_W + SSD_XBC + N_DIR * SSD_HEADS + (HY_ORDER + 1) * HY_W

kernel_name = 'hybrid_ssd_hyena_macaron_prefix_step'


def rmsnorm(x, g):
    xf = x.astype(jnp.float32)
    y = xf * lax.rsqrt(jnp.mean(xf * xf, axis=-1, keepdims=True) + RMS_EPS)
    return (y * g.astype(jnp.float32)).astype(x.dtype)


def modulate(h, shift, scale):
    return h * (1.0 + scale) + shift


def swiglu(h, w_gate, w_up, w_down):
    return jnp.dot(jax.nn.silu(jnp.dot(h, w_gate)) * jnp.dot(h, w_up), w_down)


def short_conv(x, w, b, n_rows):
    bsz, l, ch = x.shape
    k = w.shape[0]
    xr = x.reshape(bsz * n_rows, l // n_rows, ch)
    y = lax.conv_general_dilated(xr, w[:, None, :].astype(x.dtype), window_strides=(1,),
                                 padding=[((k - 1) // 2, k // 2)],
                                 dimension_numbers=('NWC', 'WIO', 'NWC'), feature_group_count=ch)
    return (y + b).reshape(bsz, l, ch)


def segsum(a):
    t = a.shape[-1]
    x = jnp.broadcast_to(a[..., :, None], a.shape + (t,))
    x = jnp.where(jnp.tril(jnp.ones((t, t), bool), -1), x, 0.0)
    s = jnp.cumsum(x, axis=-2)
    return jnp.where(jnp.tril(jnp.ones((t, t), bool)), s, -jnp.inf)


def ssd_chunked(xh, dt, a_coef, bh, ch, init):
    bsz, l, nh, hd = xh.shape
    nc = l // SSD_CHUNK

    def chunk(t):
        return t.reshape((bsz, nc, SSD_CHUNK) + t.shape[2:])

    xc = chunk(xh * dt[..., None])
    bc, cc = chunk(bh), chunk(ch)
    ac = chunk(dt * a_coef).transpose(0, 1, 3, 2)
    a_cum = jnp.cumsum(ac, axis=-1)
    scores = jnp.einsum('bclhn,bcshn->bchls', cc, bc) * jnp.exp(segsum(ac))
    y_diag = jnp.einsum('bchls,bcshp->bclhp', scores, xc)
    decay_states = jnp.exp(a_cum[..., -1:] - a_cum)
    states = jnp.einsum('bcshn,bchs,bcshp->bchpn', bc, decay_states, xc)
    states = jnp.concatenate([init[:, None], states], axis=1)
    a_chunk = jnp.pad(a_cum[..., -1], ((0, 0), (1, 0), (0, 0))).transpose(0, 2, 1)
    states = jnp.einsum('bhzc,bchpn->bzhpn', jnp.exp(segsum(a_chunk)), states)
    prev_states, final_state = states[:, :-1], states[:, -1]
    y_off = jnp.einsum('bclhn,bchpn,bchl->bclhp', cc, prev_states, jnp.exp(a_cum))
    return (y_diag + y_off).reshape(bsz, l, nh, hd), final_state


def ssd_mixer(z, xbc, dt_raw, init, n_rows, p):
    f32 = jnp.float32
    bsz, l, _ = z.shape
    xbc = jax.nn.silu(short_conv(xbc, p['ssd_conv_w'], p['ssd_conv_b'], n_rows)).astype(f32)
    xs, bm, cm = jnp.split(xbc, [SSD_W, SSD_W + SSD_GROUPS * SSD_STATE], axis=-1)
    hpg = SSD_HEADS // SSD_GROUPS
    xh = xs.reshape(bsz, l, SSD_HEADS, SSD_HEAD_DIM)
    bh = jnp.repeat(bm.reshape(bsz, l, SSD_GROUPS, SSD_STATE), hpg, axis=2)
    ch = jnp.repeat(cm.reshape(bsz, l, SSD_GROUPS, SSD_STATE), hpg, axis=2)
    dt = jax.nn.softplus(dt_raw.astype(f32).reshape(bsz, l, N_DIR, SSD_HEADS)
                         + p['ssd_dt_bias'].astype(f32))
    a_coef = -jnp.exp(p['ssd_a_log'].astype(f32))
    init = init.astype(f32)
    y_f, s_f = ssd_chunked(xh, dt[:, :, 0], a_coef[0], bh, ch, init[:, 0])
    y_b, s_b = ssd_chunked(jnp.flip(xh, 1), jnp.flip(dt[:, :, 1], 1), a_coef[1],
                           jnp.flip(bh, 1), jnp.flip(ch, 1), init[:, 1])
    y = y_f + jnp.flip(y_b, 1) + xh * p['ssd_d'].astype(f32)[:, None]
    y = y.reshape(bsz, l, SSD_W).astype(z.dtype) * jax.nn.silu(z)
    return rmsnorm(y, p['ssd_norm_w']), jnp.stack([s_f, s_b], axis=1)


def hyena_filters(l, p):
    f32 = jnp.float32
    t = jnp.linspace(0.0, 1.0, l, dtype=f32)[:, None]
    w = (2.0 * math.pi / l) * jnp.arange(l, dtype=f32)[:, None]
    f = jnp.linspace(1e-4, HY_BANDS - 1, HY_BANDS, dtype=f32)[None, :]
    feats = jnp.concatenate([t, jnp.cos(f * w), -jnp.sin(f * w)], axis=-1)
    freq = p['hy_freq'].astype(f32)
    h = jnp.sin(freq * (jnp.dot(feats, p['hy_w1'].astype(f32)) + p['hy_b1'].astype(f32)))
    h = jnp.sin(freq * (jnp.dot(h, p['hy_w2'].astype(f32)) + p['hy_b2'].astype(f32)))
    h = jnp.dot(h, p['hy_w3'].astype(f32)).reshape(l, N_DIR, HY_ORDER, HY_W)
    deltas = jnp.abs(jnp.linspace(HY_MIN_DECAY, HY_MAX_DECAY, HY_ORDER * HY_W, dtype=f32))
    window = jnp.exp(-t[:, :, None] * deltas.reshape(HY_ORDER, HY_W))
    return h * window[:, None]


def hyena_mixer(u, n_rows, p):
    bsz, l, _ = u.shape
    u = short_conv(u, p['hy_conv_w'], p['hy_conv_b'], n_rows).astype(jnp.float32)
    v, x1, x2 = jnp.split(u, 3, axis=-1)
    k = hyena_filters(l, p)
    k2 = jnp.concatenate([k[:, 0], jnp.zeros_like(k[:1, 0]), k[:0:-1, 1]], axis=0)
    kf = jnp.fft.rfft(k2, axis=0)
    skip = p['hy_skip'].astype(jnp.float32)
    zz = v
    for i, gate in enumerate((x1, x2)):
        sf = jnp.fft.rfft(zz, n=2 * l, axis=1)
        conv = jnp.fft.irfft(sf * kf[:, i], n=2 * l, axis=1)[:, :l]
        zz = gate * (conv + zz * skip[i])
    return zz


def token_mix(h, ssd_init, n_rows, p):
    proj = jnp.dot(h, p['w_in'])
    z, xbc, dt_raw, hy_in = jnp.split(
        proj, [SSD_W, SSD_W + SSD_XBC, SSD_W + SSD_XBC + N_DIR * SSD_HEADS], axis=-1)
    y_ssd, final_state = ssd_mixer(z, xbc, dt_raw, ssd_init, n_rows, p)
    y_hy = hyena_mixer(hy_in, n_rows, p).astype(h.dtype)
    return jnp.dot(jnp.concatenate([y_ssd, y_hy], axis=-1), p['w_out']), final_state


def trunk_layer(x, cond, ssd_init, n_rows, p):
    mod = jnp.dot(jax.nn.silu(cond), p['w_ada']) + p['b_ada']
    sh1, sc1, g1, sh2, sc2, g2, sh3, sc3, g3 = jnp.split(mod[:, None, :], N_MOD, axis=-1)
    h = modulate(rmsnorm(x, p['norm_ffn1']), sh1, sc1)
    x = x + 0.5 * g1 * swiglu(h, p['ffn1_w_gate'], p['ffn1_w_up'], p['ffn1_w_down'])
    h = modulate(rmsnorm(x, p['norm_mix']), sh2, sc2)
    mix, final_state = token_mix(h, ssd_init, n_rows, p)
    x = x + g2 * mix
    h = modulate(rmsnorm(x, p['norm_ffn2']), sh3, sc3)
    x = x + 0.5 * g3 * swiglu(h, p['ffn2_w_gate'], p['ffn2_w_up'], p['ffn2_w_down'])
    return x, final_state


def setup_inputs(seed: int = 0) -> dict:
    key = jax.random.key(seed)
    keys = jax.random.split(key, 34)
    f32 = jnp.float32

    def nrm(i, shape, scale):
        return scale * jax.random.normal(keys[i], shape, f32)

    def gain(i, shape):
        return 1.0 + nrm(i, shape, 0.1)

    L = DEPTH
    dt0 = jnp.exp(jax.random.uniform(keys[16], (L, N_DIR, SSD_HEADS), f32,
                                     minval=math.log(1e-3), maxval=math.log(1e-1)))
    dt_bias = dt0 + jnp.log(-jnp.expm1(-dt0))
    a_log = jnp.log(jax.random.uniform(keys[17], (L, N_DIR, SSD_HEADS), f32, minval=1.0, maxval=16.0))
    return {
        'x_prompt': nrm(0, (BATCH, SEQ, D_MODEL), 1.0),
        'x_sample': nrm(1, (DEC_BATCH, DEC_SEQ, D_MODEL), 1.0),
        'state_ssd': nrm(2, (DEC_BATCH, DEPTH, N_DIR, SSD_HEADS, SSD_HEAD_DIM, SSD_STATE), 0.5),
        'c': nrm(3, (DEC_BATCH, D_MODEL), 1.0),
        'c_ctx': nrm(4, (D_MODEL,), 1.0),
        'w_ada': nrm(5, (L, D_MODEL, N_MOD * D_MODEL), D_MODEL ** -0.5),
        'b_ada': nrm(6, (L, N_MOD * D_MODEL), 0.02),
        'norm_ffn1': gain(7, (L, D_MODEL)),
        'ffn1_w_gate': nrm(8, (L, D_MODEL, FFN_DIM), D_MODEL ** -0.5),
        'ffn1_w_up': nrm(9, (L, D_MODEL, FFN_DIM), D_MODEL ** -0.5),
        'ffn1_w_down': nrm(10, (L, FFN_DIM, D_MODEL), FFN_DIM ** -0.5),
        'norm_mix': gain(11, (L, D_MODEL)),
        'w_in': nrm(12, (L, D_MODEL, IN_COLS), D_MODEL ** -0.5),
        'w_out': nrm(13, (L, MIX_W, D_MODEL), MIX_W ** -0.5),
        'ssd_conv_w': nrm(14, (L, SSD_CONV, SSD_XBC), SSD_CONV ** -0.5),
        'ssd_conv_b': nrm(15, (L, SSD_XBC), 0.02),
        'ssd_dt_bias': dt_bias,
        'ssd_a_log': a_log,
        'ssd_d': gain(18, (L, SSD_HEADS)),
        'ssd_norm_w': gain(19, (L, SSD_W)),
        'hy_conv_w': nrm(20, (L, HY_CONV, (HY_ORDER + 1) * HY_W), HY_CONV ** -0.5),
        'hy_conv_b': nrm(21, (L, (HY_ORDER + 1) * HY_W), 0.02),
        'hy_w1': nrm(22, (L, HY_EMB, HY_FILTER_HIDDEN), HY_EMB ** -0.5),
        'hy_b1': nrm(23, (L, HY_FILTER_HIDDEN), 0.02),
        'hy_freq': gain(24, (L, HY_FILTER_HIDDEN)),
        'hy_w2': nrm(25, (L, HY_FILTER_HIDDEN, HY_FILTER_HIDDEN), HY_FILTER_HIDDEN ** -0.5),
        'hy_b2': nrm(26, (L, HY_FILTER_HIDDEN), 0.02),
        'hy_w3': nrm(27, (L, HY_FILTER_HIDDEN, N_DIR * HY_ORDER * HY_W), 0.1 * HY_FILTER_HIDDEN ** -0.5),
        'hy_skip': nrm(28, (L, HY_ORDER, HY_W), 0.5),
        'norm_ffn2': gain(29, (L, D_MODEL)),
        'ffn2_w_gate': nrm(30, (L, D_MODEL, FFN_DIM), D_MODEL ** -0.5),
        'ffn2_w_up': nrm(31, (L, D_MODEL, FFN_DIM), D_MODEL ** -0.5),
        'ffn2_w_down': nrm(32, (L, FFN_DIM, D_MODEL), FFN_DIM ** -0.5),
        'norm_final': gain(33, (D_MODEL,)),
    }


def reference(x_prompt, x_sample, state_ssd, c, c_ctx, w_ada, b_ada, norm_ffn1, ffn1_w_gate, ffn1_w_up,
              ffn1_w_down, norm_mix, w_in, w_out, ssd_conv_w, ssd_conv_b, ssd_dt_bias, ssd_a_log, ssd_d,
              ssd_norm_w, hy_conv_w, hy_conv_b, hy_w1, hy_b1, hy_freq, hy_w2, hy_b2, hy_w3, hy_skip,
              norm_ffn2, ffn2_w_gate, ffn2_w_up, ffn2_w_down, norm_final):
    rows = x_sample.shape[1] // GRID_W
    ctx_cond = c_ctx[None, :]
    h_ctx, h_lat = x_prompt, x_sample
    ctx_states = []
    for i in range(DEPTH):
        p = {
            'w_ada': w_ada[i], 'b_ada': b_ada[i], 'norm_ffn1': norm_ffn1[i],
            'ffn1_w_gate': ffn1_w_gate[i], 'ffn1_w_up': ffn1_w_up[i], 'ffn1_w_down': ffn1_w_down[i],
            'norm_mix': norm_mix[i], 'w_in': w_in[i], 'w_out': w_out[i],
            'ssd_conv_w': ssd_conv_w[i], 'ssd_conv_b': ssd_conv_b[i], 'ssd_dt_bias': ssd_dt_bias[i],
            'ssd_a_log': ssd_a_log[i], 'ssd_d': ssd_d[i], 'ssd_norm_w': ssd_norm_w[i],
            'hy_conv_w': hy_conv_w[i], 'hy_conv_b': hy_conv_b[i], 'hy_w1': hy_w1[i], 'hy_b1': hy_b1[i],
            'hy_freq': hy_freq[i], 'hy_w2': hy_w2[i], 'hy_b2': hy_b2[i], 'hy_w3': hy_w3[i],
            'hy_skip': hy_skip[i], 'norm_ffn2': norm_ffn2[i],
            'ffn2_w_gate': ffn2_w_gate[i], 'ffn2_w_up': ffn2_w_up[i], 'ffn2_w_down': ffn2_w_down[i],
        }
        ctx_init = jnp.zeros((x_prompt.shape[0], N_DIR, SSD_HEADS, SSD_HEAD_DIM, SSD_STATE), jnp.float32)
        h_ctx, ctx_final = trunk_layer(h_ctx, ctx_cond, ctx_init, 1, p)
        ctx_states.append(ctx_final)
        h_lat, _ = trunk_layer(h_lat, c, state_ssd[:, i], rows, p)
    y_prompt = rmsnorm(h_ctx, norm_final)
    y_sample = rmsnorm(h_lat, norm_final)
    new_state_ssd = jnp.stack(ctx_states, axis=1).astype(x_prompt.dtype)
    return (y_prompt, y_sample, new_state_ssd)
```

```cpp
#include <hip/hip_runtime.h>
#include <hip/hip_cooperative_groups.h>
#include <cstdio>
#include <cstdint>
namespace cg = cooperative_groups;

namespace pg8 {
#define PG8_LAS __attribute__((address_space(3)))
typedef unsigned short bf16_t;
typedef short bf16x8 __attribute__((ext_vector_type(8)));
typedef float f32x4 __attribute__((ext_vector_type(4)));
typedef unsigned u32x4 __attribute__((ext_vector_type(4)));
constexpr int BM = 256, BK = 64, HALF = 128, HTB = HALF * BK * 2  , STAGE_BYTES = 8 * HTB, NXCD = 8, WGM = 8;

__host__ __device__ __forceinline__ int lds_byte(int r, int c) { const int st = (r >> 4) * 2 + (c >> 5), rr = r & 15, cc = c & 31, ob = rr * 64 + cc * 2; return st * 1024 + (ob ^ (((ob >> 9) & 1) << 5)); }
__host__ __device__ __forceinline__ void stage_rc(int b, int& R, int& C) { const int st = b / 1024, sb = b % 1024, swz = sb ^ (((sb >> 9) & 1) << 5); R = (st >> 1) * 16 + swz / 64; C = (st & 1) * 32 + (swz % 64) / 2; }
__host__ __device__ __forceinline__ int perm32(int rho) { const int n = rho >> 4, i = rho & 15; return 8 * (i >> 2) + 4 * n + (i & 3); }

struct Unit { int pm, pn; };
struct Gemm { const bf16_t* A; const bf16_t* Bt; int M, N, K; };

struct StaticOrder {
    int nM, nN, nwg, G, c;
    __host__ __device__ void init(int M, int N, int G_, int c_) { nM = M / BM; nN = N / BM; nwg = nM * nN; G = G_; c = c_; }
    __host__ __device__ bool next(int i, Unit& u) const {
        const long L = (long)i * G + c; if (L >= nwg) return false;
        int wgid = (int)L; { const int q = nwg / NXCD, r = nwg % NXCD, xcd = wgid % NXCD, off = wgid / NXCD; wgid = (xcd < r ? xcd * (q + 1) : r * (q + 1) + (xcd - r) * q) + off; }
        const int nig = WGM * nN, gid = wgid / nig, fm = gid * WGM, gsz = (nM - fm) < WGM ? (nM - fm) : WGM;
        u.pm = fm + ((wgid % nig) % gsz); u.pn = (wgid % nig) / gsz; return true;
    }
    __device__ __forceinline__ void a_ready(const Unit&) const {}
    __device__ __forceinline__ void done(const Unit&) const {}
};

__device__ __forceinline__ unsigned cvt_pk_bf16(float lo, float hi) { unsigned r; asm volatile("v_cvt_pk_bf16_f32 %0, %1, %2" : "=v"(r) : "v"(lo), "v"(hi)); return r; }
__device__ __forceinline__ float silu_fast(float x) { return x * __builtin_amdgcn_rcpf(1.0f + __builtin_amdgcn_exp2f(-1.4426950408889634f * x)); }

struct EpiSwiGLU {
    static constexpr bool PERM = true, AFTER_DRAIN = false;
    bf16_t* O; int ldc;
    __device__ __forceinline__ void operator()(const f32x4 (&acc)[2][2][4][2], const Unit& u, int wr, int wc, int fr, int fq) const {
        const int row0 = u.pm * BM + wr * 64 + fr, col0 = u.pn * HALF + wc * 32 + 8 * fq;
#pragma unroll
        for (int ai = 0; ai < 2; ++ai)
#pragma unroll
            for (int m = 0; m < 4; ++m) { bf16_t* rowp = O + (size_t)(row0 + ai * HALF + m * 16) * ldc + col0;
                const f32x4 g0 = acc[ai][0][m][0], g1 = acc[ai][0][m][1], u0 = acc[ai][1][m][0], u1 = acc[ai][1][m][1];
                u32x4 w; w.x = cvt_pk_bf16(silu_fast(g0[0]) * u0[0], silu_fast(g0[1]) * u0[1]); w.y = cvt_pk_bf16(silu_fast(g0[2]) * u0[2], silu_fast(g0[3]) * u0[3]);
                w.z = cvt_pk_bf16(silu_fast(g1[0]) * u1[0], silu_fast(g1[1]) * u1[1]); w.w = cvt_pk_bf16(silu_fast(g1[2]) * u1[2], silu_fast(g1[3]) * u1[3]);
                *(u32x4*)rowp = w; }
    }
};
struct EpiResid {
    static constexpr bool PERM = false, AFTER_DRAIN = false;
    const float* base0; const float* base1; float* out; const float* gmod; float scale;
    __device__ __forceinline__ void operator()(const f32x4 (&acc)[2][2][4][2], const Unit& u, int wr, int wc, int fr, int fq) const {
        const int row0 = u.pm * BM + wr * 64 + fr, col0 = u.pn * BM + wc * 32 + 4 * fq;
        const bool ctx = u.pm < 16; const int modrow = ctx ? 8 : ((u.pm - 16) >> 2);
        const float* bp = ctx ? base0 : base1 - (size_t)4096 * 1024;
        const float* gp = gmod + (size_t)modrow * 9216 + col0;
        f32x4 gv[2][2];
#pragma unroll
        for (int bj = 0; bj < 2; ++bj)
#pragma unroll
            for (int n = 0; n < 2; ++n) gv[bj][n] = *(const f32x4*)(gp + bj * HALF + n * 16) * scale;
#pragma unroll
        for (int ai = 0; ai < 2; ++ai)
#pragma unroll
            for (int m = 0; m < 4; ++m) { const size_t off = (size_t)(row0 + ai * HALF + m * 16) * 1024 + col0;
#pragma unroll
                for (int bj = 0; bj < 2; ++bj)
#pragma unroll
                    for (int n = 0; n < 2; ++n) { const f32x4 b = *(const f32x4*)(bp + off + bj * HALF + n * 16); *(f32x4*)(out + off + bj * HALF + n * 16) = b + gv[bj][n] * acc[ai][bj][m][n]; } }
    }
};
struct EpiProj {
    static constexpr bool PERM = true, AFTER_DRAIN = false;
    bf16_t* P; float* DT;
    __device__ __forceinline__ void operator()(const f32x4 (&acc)[2][2][4][2], const Unit& u, int wr, int wc, int fr, int fq) const {
        const int row0 = u.pm * BM + wr * 64 + fr;
        if (u.pn < 11) {
            const int col0 = u.pn * BM + wc * 32 + 8 * fq;
#pragma unroll
            for (int ai = 0; ai < 2; ++ai)
#pragma unroll
                for (int m = 0; m < 4; ++m) { bf16_t* rowp = P + (size_t)(row0 + ai * HALF + m * 16) * 3072 + col0;
#pragma unroll
                    for (int bj = 0; bj < 2; ++bj) { const f32x4 v0 = acc[ai][bj][m][0], v1 = acc[ai][bj][m][1];
                        u32x4 w; w.x = cvt_pk_bf16(v0[0], v0[1]); w.y = cvt_pk_bf16(v0[2], v0[3]); w.z = cvt_pk_bf16(v1[0], v1[1]); w.w = cvt_pk_bf16(v1[2], v1[3]);
                        *(u32x4*)(rowp + bj * HALF) = w; } }
        } else if (wc == 0 && fq < 2) {
#pragma unroll
            for (int ai = 0; ai < 2; ++ai)
#pragma unroll
                for (int m = 0; m < 4; ++m) { float* rowp = DT + (size_t)(row0 + ai * HALF + m * 16) * 16 + 8 * fq;
                    *(f32x4*)(rowp) = acc[ai][0][m][0]; *(f32x4*)(rowp + 4) = acc[ai][0][m][1]; }
        }
    }
};

template <class Epi, class Sched, bool ALIGN_EPI = false, bool SP2 = false>
__device__ __forceinline__ void gemm_phase(PG8_LAS unsigned char* lds, const Gemm g, const Sched& S, const Epi& E) {
    int tid_ = threadIdx.x; asm volatile("" : "+v"(tid_));
    const int tid = tid_, wid = __builtin_amdgcn_readfirstlane(tid >> 6), lane = tid & 63, wr = wid >> 2, wc = wid & 3, fr = lane & 15, fq = lane >> 4;
    const int K = g.K, nt = K / BK;
    unsigned voffA[2], voffB[2];
#pragma unroll
    for (int i = 0; i < 2; ++i) { int R, C; stage_rc(tid * 16 + i * 8192, R, C); const int Rb = Epi::PERM ? ((R & ~31) + perm32(R & 31)) : R;
        voffA[i] = (unsigned)(R * K + C) * 2u; voffB[i] = (unsigned)(Rb * K + C) * 2u; }
    const size_t kstep = (size_t)(BK * 2);
    const size_t hstep = (size_t)HALF * K * 2;
    const size_t tstep = 2 * hstep;
    const unsigned ldsw = (unsigned)wid * 1024u;
    const int aoff = lds_byte(wr * 64 + fr, fq * 8), boff = lds_byte(wc * 32 + fr, fq * 8);
#define PG8_SA(b, h) (((b) * 2 + (h)) * HTB)
#define PG8_SB(b, h) ((4 + (b) * 2 + (h)) * HTB)
#define PG8_STAGE(bufoff, gbase, voff) do { _Pragma("unroll") for (int _i = 0; _i < 2; ++_i) \
        __builtin_amdgcn_global_load_lds((const unsigned*)((const char*)(gbase) + (voff)[_i]), (PG8_LAS unsigned*)(lds + (bufoff) + ldsw + _i * 8192), 16, 0, 0); } while (0)
#define PG8_LDA(dst, b, h) do { _Pragma("unroll") for (int m = 0; m < 4; ++m) _Pragma("unroll") for (int k = 0; k < 2; ++k) dst[m][k] = *(const PG8_LAS bf16x8*)(lds + PG8_SA(b, h) + aoff + m * 2048 + k * 1024); } while (0)
#define PG8_LDB(dst, b, h) do { _Pragma("unroll") for (int n = 0; n < 2; ++n) _Pragma("unroll") for (int k = 0; k < 2; ++k) dst[n][k] = *(const PG8_LAS bf16x8*)(lds + PG8_SB(b, h) + boff + n * 2048 + k * 1024); } while (0)
#define PG8_MMA(ai, bj, At, Bt) do { __builtin_amdgcn_s_setprio(1); _Pragma("unroll") for (int m = 0; m < 4; ++m) _Pragma("unroll") for (int n = 0; n < 2; ++n) _Pragma("unroll") for (int k = 0; k < 2; ++k) \
        acc[ai][bj][m][n] = __builtin_amdgcn_mfma_f32_16x16x32_bf16(Bt[n][k], At[m][k], acc[ai][bj][m][n], 0, 0, 0); __builtin_amdgcn_s_setprio(0); } while (0)
#define PG8_WAIT_V(n) asm volatile("s_waitcnt vmcnt(" #n ")" ::: "memory")
#define PG8_WAIT_L(n) asm volatile("s_waitcnt lgkmcnt(" #n ")" ::: "memory")
#define PG8_BAR __builtin_amdgcn_s_barrier()
#define PG8_SCHED __builtin_amdgcn_sched_barrier(0)
    Unit cur, nxt; int ui = 0;
    if (!S.next(0, cur)) return;
    f32x4 acc[2][2][4][2];
#pragma unroll
    for (int a = 0; a < 2; ++a)
#pragma unroll
        for (int b = 0; b < 2; ++b)
#pragma unroll
            for (int m = 0; m < 4; ++m)
#pragma unroll
                for (int n = 0; n < 2; ++n) acc[a][b][m][n] = (f32x4){0.f, 0.f, 0.f, 0.f};
    bf16x8 At[4][2], B0[2][2], B1[2][2];
    const char* cA = (const char*)g.A + (size_t)cur.pm * tstep; const char* cB = (const char*)g.Bt + (size_t)cur.pn * tstep;
    S.a_ready(cur);
    if constexpr (SP2) {
        PG8_STAGE(PG8_SB(0, 0), cB, voffB); PG8_STAGE(PG8_SB(0, 1), cB + hstep, voffB); PG8_STAGE(PG8_SA(0, 0), cA, voffA); PG8_STAGE(PG8_SA(0, 1), cA + hstep, voffA);
        if (wr == 1) PG8_BAR;
        PG8_WAIT_V(2); PG8_BAR;
        PG8_STAGE(PG8_SB(1, 0), cB + kstep, voffB); PG8_STAGE(PG8_SA(1, 0), cA + kstep, voffA); PG8_STAGE(PG8_SB(1, 1), cB + hstep + kstep, voffB);
        PG8_WAIT_V(6); PG8_BAR;
    } else {
        PG8_STAGE(PG8_SB(0, 0), cB, voffB); PG8_STAGE(PG8_SA(0, 0), cA, voffA); PG8_STAGE(PG8_SB(0, 1), cB + hstep, voffB); PG8_STAGE(PG8_SA(0, 1), cA + hstep, voffA);
        if (wr == 1) PG8_BAR;
        PG8_WAIT_V(4); PG8_BAR;
        PG8_STAGE(PG8_SB(1, 0), cB + kstep, voffB); PG8_STAGE(PG8_SA(1, 0), cA + kstep, voffA); PG8_STAGE(PG8_SB(1, 1), cB + hstep + kstep, voffB);
        PG8_WAIT_V(6); PG8_BAR;
    }
    for (;;) {
        const bool has_next = S.next(ui + 1, nxt);
        const char* nA = has_next ? (const char*)g.A + (size_t)nxt.pm * tstep : cA; const char* nB = has_next ? (const char*)g.Bt + (size_t)nxt.pn * tstep : cB;
        for (int t = 0; t < nt; t += 2) {
            const bool last = (t == nt - 2);
            const char* a1 = cA + (size_t)(t + 1) * kstep;
            const char* a2 = last ? nA : cA + (size_t)(t + 2) * kstep; const char* b2 = last ? nB : cB + (size_t)(t + 2) * kstep;
            const char* a3 = a2 + kstep; const char* b3 = b2 + kstep;
            if (last && has_next) S.a_ready(nxt);
            if constexpr (SP2) {
            PG8_LDB(B0, 0, 0); PG8_LDB(B1, 0, 1); PG8_SCHED; PG8_LDA(At, 0, 0); PG8_STAGE(PG8_SA(1, 1), a1 + hstep, voffA);
            PG8_WAIT_V(8); PG8_WAIT_L(0); PG8_BAR; PG8_MMA(0, 0, At, B0); PG8_MMA(0, 1, At, B1); PG8_BAR; PG8_SCHED;
            PG8_LDA(At, 0, 1); PG8_STAGE(PG8_SB(0, 0), b2, voffB); PG8_STAGE(PG8_SB(0, 1), b2 + hstep, voffB); PG8_STAGE(PG8_SA(0, 0), a2, voffA);
            PG8_WAIT_V(8); PG8_WAIT_L(0); PG8_BAR; PG8_MMA(1, 0, At, B0); PG8_MMA(1, 1, At, B1); PG8_BAR; PG8_SCHED;
            PG8_LDB(B0, 1, 0); PG8_LDB(B1, 1, 1); PG8_SCHED; PG8_LDA(At, 1, 0); PG8_STAGE(PG8_SA(0, 1), a2 + hstep, voffA);
            PG8_WAIT_V(8); PG8_WAIT_L(0); PG8_BAR; PG8_MMA(0, 0, At, B0); PG8_MMA(0, 1, At, B1); PG8_BAR; PG8_SCHED;
            PG8_LDA(At, 1, 1); PG8_STAGE(PG8_SB(1, 0), b3, voffB); PG8_STAGE(PG8_SB(1, 1), b3 + hstep, voffB); PG8_STAGE(PG8_SA(1, 0), a3, voffA);
            PG8_WAIT_V(8); PG8_WAIT_L(0); PG8_BAR; PG8_MMA(1, 0, At, B0); PG8_MMA(1, 1, At, B1); PG8_BAR; PG8_SCHED;
            } else {
            PG8_LDB(B0, 0, 0); PG8_SCHED; PG8_LDA(At, 0, 0); PG8_STAGE(PG8_SA(1, 1), a1 + hstep, voffA);
            PG8_WAIT_L(8); PG8_BAR; PG8_WAIT_L(0); PG8_MMA(0, 0, At, B0); PG8_BAR; PG8_SCHED;
            PG8_LDB(B1, 0, 1); PG8_STAGE(PG8_SB(0, 0), b2, voffB);
            PG8_BAR; PG8_WAIT_L(0); PG8_MMA(0, 1, At, B1); PG8_BAR;
            PG8_LDA(At, 0, 1); PG8_STAGE(PG8_SA(0, 0), a2, voffA);
            PG8_BAR; PG8_WAIT_L(0); PG8_MMA(1, 0, At, B0); PG8_BAR; PG8_SCHED;
            PG8_STAGE(PG8_SB(0, 1), b2 + hstep, voffB);
            PG8_WAIT_V(6); PG8_BAR; PG8_MMA(1, 1, At, B1); PG8_BAR;
            PG8_LDB(B0, 1, 0); PG8_SCHED; PG8_LDA(At, 1, 0); PG8_STAGE(PG8_SA(0, 1), a2 + hstep, voffA);
            PG8_WAIT_L(8); PG8_BAR; PG8_WAIT_L(0); PG8_MMA(0, 0, At, B0); PG8_BAR; PG8_SCHED;
            PG8_LDB(B1, 1, 1); PG8_STAGE(PG8_SB(1, 0), b3, voffB);
            PG8_BAR; PG8_WAIT_L(0); PG8_MMA(0, 1, At, B1); PG8_BAR;
            PG8_LDA(At, 1, 1); PG8_STAGE(PG8_SA(1, 0), a3, voffA);
            PG8_BAR; PG8_WAIT_L(0); PG8_MMA(1, 0, At, B0); PG8_BAR; PG8_SCHED;
            PG8_STAGE(PG8_SB(1, 1), b3 + hstep, voffB);
            PG8_WAIT_V(6); PG8_BAR; PG8_MMA(1, 1, At, B1); PG8_BAR;
            }
        }
        if constexpr (ALIGN_EPI) { if (wr == 0) PG8_BAR; }
        if constexpr (!Epi::AFTER_DRAIN) { E(acc, cur, wr, wc, fr, fq); S.done(cur); }
        if (!has_next) break;
#pragma unroll
        for (int a = 0; a < 2; ++a)
#pragma unroll
            for (int b = 0; b < 2; ++b)
#pragma unroll
                for (int m = 0; m < 4; ++m)
#pragma unroll
                    for (int n = 0; n < 2; ++n) acc[a][b][m][n] = (f32x4){0.f, 0.f, 0.f, 0.f};
        cur = nxt; cA = nA; cB = nB; ++ui;
        if constexpr (ALIGN_EPI) { if (wr == 1) PG8_BAR; }
    }
    PG8_WAIT_V(0);
    if constexpr (!ALIGN_EPI) { if (wr == 0) PG8_BAR; }
    PG8_BAR;
    if constexpr (Epi::AFTER_DRAIN) { E.fused(acc, cur, wr, wc, fr, fq, lds, wid, lane); S.done(cur); }
#undef PG8_SA
#undef PG8_SB
#undef PG8_STAGE
#undef PG8_LDA
#undef PG8_LDB
#undef PG8_MMA
#undef PG8_WAIT_V
#undef PG8_WAIT_L
#undef PG8_BAR
#undef PG8_SCHED
}
}

#define LAS __attribute__((address_space(3)))
typedef unsigned short bf16;
typedef float f32x4 __attribute__((ext_vector_type(4)));
typedef unsigned u32x4 __attribute__((ext_vector_type(4)));
typedef unsigned u32x2 __attribute__((ext_vector_type(2)));
typedef short bf16x8 __attribute__((ext_vector_type(8)));
struct __attribute__((packed, aligned(2))) bf16x8_u { bf16x8 v; };

constexpr int DM = 1024, NTOK = 12288, NCTX = 4096, FF = 2752, FFP = 2816, NPROJ = 3072, MODW = 9216, INC = 2832;
constexpr float RMS_EPS = 1e-6f;
constexpr int NTHR = 512, NWAVES = 8;
constexpr int LDS_BYTES = 132096;
constexpr size_t MiB = 1u << 20;
constexpr size_t WS_MOD = 1 * MiB, WS_DT = 2 * MiB, WS_RF0 = 3 * MiB, WS_RF1 = 4 * MiB;
constexpr size_t WS_WB1 = 8 * MiB, WS_WD1 = 19 * MiB, WS_WB2 = 25 * MiB, WS_WD2 = 36 * MiB, WS_WIN = 42 * MiB, WS_WOUT = 48 * MiB;
constexpr size_t WS_H = 50 * MiB;
constexpr size_t WS_U = 74 * MiB;
constexpr size_t WS_X2 = 146 * MiB;
constexpr size_t WS_VT = 194 * MiB;
constexpr size_t WS_XC = 231 * MiB;
constexpr size_t WS_H2G = 250 * MiB;
constexpr size_t WS_END = 251 * MiB;

struct Args { const float* in[34]; float* out; unsigned char* ws; };

__device__ __forceinline__ unsigned pk2(float lo, float hi) { unsigned r; asm("v_cvt_pk_bf16_f32 %0, %1, %2" : "=v"(r) : "v"(lo), "v"(hi)); return r; }
__device__ __forceinline__ unsigned f2bf(float f) { return pk2(f, 0.f) & 0xffffu; }
__device__ __forceinline__ float bf2f(unsigned b) { return __uint_as_float(b << 16); }
__device__ __forceinline__ float silu_f(float x) { return x * __builtin_amdgcn_rcpf(1.0f + __builtin_amdgcn_exp2f(-1.4426950408889634f * x)); }
__device__ __forceinline__ float wave_sum(float v) {
#pragma unroll
    for (int o = 1; o < 64; o <<= 1) v += __shfl_xor(v, o);
    return v;
}
#define LDS_WAIT() asm volatile("s_waitcnt lgkmcnt(0)" ::: "memory")

__device__ __forceinline__ void ada_phase(const float* c, const float* c_ctx, const float* w_ada, const float* b_ada, float* MOD, unsigned char* lds, int bid, int G) {
    const int tid = threadIdx.x;
    float* sc = (float*)lds; float* red = sc + 9 * 1024;
    if (bid >= 288) return;
    for (int e = tid; e < 9 * 1024; e += NTHR) { const int r = e >> 10, k = e & 1023; const float cv = r < 8 ? c[r * 1024 + k] : c_ctx[k]; sc[e] = silu_f(cv); }
    __syncthreads();
    for (int item = bid; item < 288; item += G) {
        const int col0 = item * 32, cq = tid & 7, ks = tid >> 3;
        f32x4 acc[9];
#pragma unroll
        for (int r = 0; r < 9; ++r) acc[r] = (f32x4){0.f, 0.f, 0.f, 0.f};
        const float* wp = w_ada + (size_t)(ks * 16) * MODW + col0 + 4 * cq;
        f32x4 w[16];
#pragma unroll
        for (int kk = 0; kk < 16; ++kk) w[kk] = *(const f32x4*)(wp + (size_t)kk * MODW);
#pragma unroll
        for (int kk = 0; kk < 16; ++kk) {
#pragma unroll
            for (int r = 0; r < 9; ++r) acc[r] += sc[r * 1024 + ks * 16 + kk] * w[kk]; }
#pragma unroll
        for (int r = 0; r < 9; ++r) *(f32x4*)(red + (ks * 9 + r) * 32 + 4 * cq) = acc[r];
        __syncthreads();
        if (tid < 288) { const int r = tid >> 5, col = tid & 31; float sum = b_ada[col0 + col];
            for (int k2 = 0; k2 < 64; ++k2) sum += red[(k2 * 9 + r) * 32 + col];
            MOD[r * MODW + col0 + col] = sum; }
        __syncthreads();
    }
}

struct TrItem { const float* W; bf16* dst; int ldw, kvalid, srccol4, Kdst, drow0, k0; };
constexpr int TR_I_WB = 16 * 176, TR_I_WD = 44 * 32, TR_I_WIN = 16 * 96, TR_I_WOUT = 16 * 32, TR_NITEMS = 2 * TR_I_WB + 2 * TR_I_WD + TR_I_WIN + TR_I_WOUT;
__device__ __forceinline__ TrItem tr_item(const Args& a, int r, int lane) {
    unsigned char* ws = a.ws; const int q4 = 4 * (lane & 7); TrItem t;
    if (r < 2 * TR_I_WB) { const int f = r / TR_I_WB; r -= f * TR_I_WB; const int kb = r / 176, nb = r % 176, n = nb * 32 + q4;
        const int pn = n >> 8, w = n & 255, bj = w >> 7, col = pn * 128 + (w & 127);
        t.W = bj ? a.in[f ? 31 : 9] : a.in[f ? 30 : 8]; t.ldw = FF; t.kvalid = 1024; t.srccol4 = col < FF ? col : -1; t.dst = (bf16*)(ws + (f ? WS_WB2 : WS_WB1)); t.Kdst = 1024; t.drow0 = nb * 32; t.k0 = kb * 64; return t; }
    r -= 2 * TR_I_WB;
    if (r < 2 * TR_I_WD) { const int f = r / TR_I_WD; r -= f * TR_I_WD; const int kb = r / 32, nb = r % 32;
        t.W = a.in[f ? 32 : 10]; t.ldw = 1024; t.kvalid = FF; t.srccol4 = nb * 32 + q4; t.dst = (bf16*)(ws + (f ? WS_WD2 : WS_WD1)); t.Kdst = FFP; t.drow0 = nb * 32; t.k0 = kb * 64; return t; }
    r -= 2 * TR_I_WD;
    if (r < TR_I_WIN) { const int kb = r / 96, nb = r % 96, n = nb * 32 + q4;
        t.W = a.in[12]; t.ldw = INC; t.kvalid = 1024; t.srccol4 = n < 1280 ? n : (n < 2816 ? n + 16 : (n < 2832 ? n - 1536 : -1)); t.dst = (bf16*)(ws + WS_WIN); t.Kdst = 1024; t.drow0 = nb * 32; t.k0 = kb * 64; return t; }
    r -= TR_I_WIN;
    { const int kb = r / 32, nb = r % 32;
        t.W = a.in[13]; t.ldw = 1024; t.kvalid = 1024; t.srccol4 = nb * 32 + q4; t.dst = (bf16*)(ws + WS_WOUT); t.Kdst = 1024; t.drow0 = nb * 32; t.k0 = kb * 64; return t; }
}
__device__ __forceinline__ int tr_nitems(int set) { return set == 2 ? TR_NITEMS : (set == 0 ? TR_I_WB : (set == 1 ? TR_I_WD : (set == 3 ? TR_I_WD + TR_I_WIN + TR_I_WOUT : TR_I_WB / 2))); }
__device__ __forceinline__ int tr_canon(int set, int i) {
    if (set == 2 || set == 0) return i;
    if (set == 1) return 2 * TR_I_WB + TR_I_WD + i;
    if (set == 4) return TR_I_WB + i;
    if (set == 5) return TR_I_WB + TR_I_WB / 2 + i;
    if (i < TR_I_WD) return 2 * TR_I_WB + i;
    return 2 * TR_I_WB + 2 * TR_I_WD + (i - TR_I_WD);
}
__device__ __forceinline__ void transpose_phase(const Args& a, unsigned char* lds, int gw, int NGW, int wave, int lane, int set) {
    float* scr = (float*)(lds + wave * 16384);
    const int nit = tr_nitems(set);
    if (gw >= nit) return;
    f32x4 v[8]; TrItem cur = tr_item(a, tr_canon(set, gw), lane);
#define TR_LOAD(t_) do { _Pragma("unroll") for (int i = 0; i < 8; ++i) { const int k = (t_).k0 + 8 * i + (lane >> 3); v[i] = (f32x4){0.f, 0.f, 0.f, 0.f}; \
        if ((t_).srccol4 >= 0 && k < (t_).kvalid) v[i] = *(const f32x4*)((t_).W + (size_t)k * (t_).ldw + (t_).srccol4); } } while (0)
    TR_LOAD(cur);
    for (int it0 = gw; it0 < nit; it0 += NGW) {
#pragma unroll
        for (int i = 0; i < 8; ++i) { float* q = scr + (8 * i + (lane >> 3)) * 33 + 4 * (lane & 7); q[0] = v[i].x; q[1] = v[i].y; q[2] = v[i].z; q[3] = v[i].w; }
        const TrItem done = cur;
        if (it0 + NGW < nit) { cur = tr_item(a, tr_canon(set, it0 + NGW), lane); TR_LOAD(cur); }
        LDS_WAIT();
        const int c = lane & 7;
#pragma unroll
        for (int j = 0; j < 4; ++j) { const int n = (lane >> 3) + 8 * j; const float* sp = scr + (8 * c) * 33 + n;
            u32x4 o; o.x = pk2(sp[0 * 33], sp[1 * 33]); o.y = pk2(sp[2 * 33], sp[3 * 33]); o.z = pk2(sp[4 * 33], sp[5 * 33]); o.w = pk2(sp[6 * 33], sp[7 * 33]);
            *(u32x4*)(done.dst + (size_t)(done.drow0 + n) * done.Kdst + done.k0 + 8 * c) = o; }
        LDS_WAIT();
    }
#undef TR_LOAD
}

__device__ __forceinline__ void filter_phase(const Args& a, unsigned char* lds, int bid, int G) {
    const int tid = threadIdx.x, pos = tid >> 6, i = tid & 63;
    float* feats = (float*)lds; float* h1 = feats + 8 * 64; float* h2 = h1 + 8 * 64; float* tt = h2 + 8 * 64;
    const float* w1 = a.in[22]; const float* b1 = a.in[23]; const float* freq = a.in[24]; const float* w2 = a.in[25]; const float* b2 = a.in[26]; const float* w3 = a.in[27];
    const float MIND = -3.0701134573253944f, MAXD = -15.350567286626972f;
    for (int base = 0; base < 1280; base += 8 * G) {
        const int slot = base + pos * G + bid; const bool live = slot < 1280;
        const int item = (slot & 7) * 160 + (slot >> 3);
        const int lt = item < 256 ? 0 : 1, j = lt ? item - 256 : item, L = lt ? 1024 : 256;
        const float t = (float)j / (float)(L - 1), w = (6.283185307179586f / (float)L) * (float)j;
        __syncthreads();
        if (live && i < 33) { float v;
            if (i == 0) v = t;
            else { const int m = (i - 1) & 15; const float f = 1e-4f + (float)m * ((15.0f - 1e-4f) / 15.0f); v = i <= 16 ? cosf(f * w) : -sinf(f * w); }
            feats[pos * 64 + i] = v; if (i == 0) tt[pos] = t; }
        __syncthreads();
        if (live) { float sum = b1[i];
#pragma unroll 11
            for (int q = 0; q < 33; ++q) sum += feats[pos * 64 + q] * w1[q * 64 + i];
            h1[pos * 64 + i] = sinf(freq[i] * sum); }
        __syncthreads();
        if (live) { float sum = b2[i];
#pragma unroll 16
            for (int q = 0; q < 64; ++q) sum += h1[pos * 64 + q] * w2[q * 64 + i];
            h2[pos * 64 + i] = sinf(freq[i] * sum); }
        __syncthreads();
#pragma unroll 1
        for (int e = 0; e < 4; ++e) { const int col = tid + 512 * e;
            float wq[64];
#pragma unroll
            for (int q = 0; q < 64; ++q) wq[q] = w3[q * 2048 + col];
            const int dir = col >> 10, order = (col >> 9) & 1, c = col & 511;
            const float delta = fabsf(MIND + (float)(order * 512 + c) * ((MAXD - MIND) / 1023.0f));
#pragma unroll 1
            for (int pp = 0; pp < 8; ++pp) { const int sl2 = base + pp * G + bid; if (sl2 >= 1280) break; const int it2 = (sl2 & 7) * 160 + (sl2 >> 3);
                const int lt2 = it2 < 256 ? 0 : 1, j2 = lt2 ? it2 - 256 : it2, L2 = lt2 ? 1024 : 256;
                float sum = 0.f;
#pragma unroll
                for (int q = 0; q < 64; ++q) sum += h2[pp * 64 + q] * wq[q];
                float val = sum * expf(-tt[pp] * delta);
                int u = dir ? L2 + j2 : L2 - j2; if (dir && j2 == 0) { u = 0; val = 0.f; }
                bf16* RF = (bf16*)(a.ws + (lt2 ? WS_RF1 : WS_RF0));
                RF[((size_t)order * 512 + c) * (2 * L2) + u] = (bf16)f2bf(val); } }
    }
}

__device__ __forceinline__ void filter_h2_phase(const Args& a, float* H2G, unsigned char* lds, int bid, int G) {
    const int tid = threadIdx.x, pos = tid >> 6, i = tid & 63;
    float* feats = (float*)lds; float* h1 = feats + 8 * 64; float* w1s = h1 + 8 * 64; float* w2s = w1s + 33 * 64;
    const float* w1 = a.in[22]; const float* b1 = a.in[23]; const float* freq = a.in[24]; const float* w2 = a.in[25]; const float* b2 = a.in[26];
    __syncthreads();
    for (int e = tid; e < 33 * 64; e += NTHR) w1s[e] = w1[e];
    for (int e = tid; e < 64 * 64; e += NTHR) w2s[e] = w2[e];
    const float b1i = b1[i], b2i = b2[i], fri = freq[i];
    for (int base = 0; base < 1280; base += 8 * G) {
        const int item = base + pos * G + bid; const bool live = item < 1280;
        const int lt = item < 256 ? 0 : 1, j = lt ? item - 256 : item, L = lt ? 1024 : 256;
        const float t = (float)j / (float)(L - 1), w = (6.283185307179586f / (float)L) * (float)j;
        __syncthreads();
        if (live && i < 33) { float v;
            if (i == 0) v = t;
            else { const int m = (i - 1) & 15; const float f = 1e-4f + (float)m * ((15.0f - 1e-4f) / 15.0f); v = i <= 16 ? cosf(f * w) : -sinf(f * w); }
            feats[pos * 64 + i] = v; }
        __syncthreads();
        if (live) { float sum = b1i;
#pragma unroll 11
            for (int q = 0; q < 33; ++q) sum += feats[pos * 64 + q] * w1s[q * 64 + i];
            h1[pos * 64 + i] = sinf(fri * sum); }
        __syncthreads();
        if (live) { float sum = b2i;
#pragma unroll 16
            for (int q = 0; q < 64; ++q) sum += h1[pos * 64 + q] * w2s[q * 64 + i];
            H2G[(size_t)item * 64 + i] = sinf(fri * sum); }
    }
}
__device__ __forceinline__ void filter_out_phase(const Args& a, const float* H2G, unsigned char* lds, int bidx) {
    const int tid = threadIdx.x, lane = tid & 63, wave = __builtin_amdgcn_readfirstlane(tid >> 6);
    float* w3s = (float*)lds;
    const float* w3 = a.in[27];
    const float MIND = -3.0701134573253944f, MAXD = -15.350567286626972f;
    __syncthreads();
    for (int e = tid; e < 64 * 16; e += NTHR) w3s[e] = w3[(size_t)(e >> 4) * 2048 + 16 * bidx + (e & 15)];
    __syncthreads();
    for (int chunk = wave; chunk < 20; chunk += 8) {
        const int item = chunk * 64 + lane, lt = chunk < 4 ? 0 : 1, j = lt ? item - 256 : item, L = lt ? 1024 : 256;
        const float t = (float)j / (float)(L - 1);
        f32x4 h[16];
#pragma unroll
        for (int k = 0; k < 16; ++k) h[k] = *(const f32x4*)(H2G + (size_t)item * 64 + 4 * k);
        f32x4 acc[4];
#pragma unroll
        for (int c4 = 0; c4 < 4; ++c4) acc[c4] = (f32x4){0.f, 0.f, 0.f, 0.f};
#pragma unroll
        for (int k = 0; k < 16; ++k) {
#pragma unroll
            for (int e = 0; e < 4; ++e) { const int q = 4 * k + e; const float hv = h[k][e];
#pragma unroll
                for (int c4 = 0; c4 < 4; ++c4) acc[c4] += hv * *(const f32x4*)(w3s + q * 16 + 4 * c4); }
            asm volatile("" ::: "memory"); }
        bf16* RF = (bf16*)(a.ws + (lt ? WS_RF1 : WS_RF0));
#pragma unroll
        for (int c4 = 0; c4 < 4; ++c4)
#pragma unroll
            for (int e = 0; e < 4; ++e) { const int col = 16 * bidx + 4 * c4 + e, dir = col >> 10, order = (col >> 9) & 1, c = col & 511;
                const float delta = fabsf(MIND + (float)(order * 512 + c) * ((MAXD - MIND) / 1023.0f));
                float val = acc[c4][e] * __expf(-t * delta);
                int u = dir ? L + j : L - j; if (dir && j == 0) { u = 0; val = 0.f; }
                RF[((size_t)order * 512 + c) * (2 * L) + u] = (bf16)f2bf(val); }
    }
}

template <int MODE>
__device__ __forceinline__ void norm_rows(const float* X0, const float* X1, const float* normw, const float* MOD, int shoff, int scoff, bf16* __restrict__ H, float* OUT, int gw, int NGW, int lane) {
#pragma unroll 2
    for (int row = gw; row < NTOK; row += NGW) {
        const float* xp = row < NCTX ? X0 + (size_t)row * DM : X1 + (size_t)(row - NCTX) * DM;
        const f32x4* xr = (const f32x4*)xp + lane;
        f32x4 v[4]; float s = 0.f;
#pragma unroll
        for (int j = 0; j < 4; ++j) { v[j] = xr[64 * j]; s += (v[j].x * v[j].x + v[j].y * v[j].y) + (v[j].z * v[j].z + v[j].w * v[j].w); }
        const float rstd = 1.0f / sqrtf(wave_sum(s) * (1.0f / DM) + RMS_EPS);
        if (MODE == 1) {
#pragma unroll
            for (int j = 0; j < 4; ++j) { const f32x4 w = ((const f32x4*)normw)[lane + 64 * j]; ((f32x4*)(OUT + (size_t)row * DM))[lane + 64 * j] = v[j] * rstd * w; }
        } else {
            const int modrow = row < NCTX ? 8 : ((row - NCTX) >> 10);
            const float* mp = MOD + (size_t)modrow * MODW;
#pragma unroll
            for (int j = 0; j < 4; ++j) { const int q = lane + 64 * j;
                const f32x4 w = ((const f32x4*)normw)[q], scv = ((const f32x4*)(mp + scoff))[q], shv = ((const f32x4*)(mp + shoff))[q];
                const f32x4 h = v[j] * rstd * w * (1.0f + scv) + shv;
                u32x2 o; o.x = pk2(h.x, h.y); o.y = pk2(h.z, h.w);
                *(u32x2*)(H + (size_t)row * DM + 4 * q) = o; }
        }
    }
}

__device__ __forceinline__ void hyconv_phase(const bf16* P, const float* cw, const float* cb, bf16* VT, unsigned char* lds, int bid, int G) {
    constexpr int RS = 258, NIT = 192 * 6;
    const int tid = threadIdx.x;
    unsigned short* raw = (unsigned short*)lds;
    u32x4 pre[5];
#define HYC_LOAD(it_) do { const int tb_ = (it_) / 6, cq_ = (it_) - tb_ * 6, r0_ = tb_ * 64; \
        _Pragma("unroll") for (int k = 0; k < 5; ++k) { const int vid = tid + 512 * k; pre[k] = (u32x4){0u, 0u, 0u, 0u}; \
            if (vid < 66 * 32) { const int i = vid >> 5, v = vid & 31, row = r0_ - 1 + i; \
                if (row >= 0 && row < NTOK) pre[k] = *(const u32x4*)(P + (size_t)row * NPROJ + 1280 + cq_ * 256 + 8 * v); } } } while (0)
    const int first = bid, step = G, last = NIT;
    int item = first;
    if (item < last) HYC_LOAD(item);
    for (; item < last; item += step) {
        const int tb = item / 6, cq = item - tb * 6, r0 = tb * 64, SL = r0 < NCTX ? 256 : 64;
        __syncthreads();
#pragma unroll
        for (int k = 0; k < 5; ++k) { const int vid = tid + 512 * k;
            if (vid < 66 * 32) { const int i = vid >> 5, v = vid & 31; unsigned* q = (unsigned*)(raw + i * RS + 8 * v); q[0] = pre[k].x; q[1] = pre[k].y; q[2] = pre[k].z; q[3] = pre[k].w; } }
        if (item + step < last) HYC_LOAD(item + step);
        __syncthreads();
        const int t = tid & 63, cg = __builtin_amdgcn_readfirstlane(tid >> 6), pos = (r0 + t) & (SL - 1);
        const bool hasp = pos != 0, hasn = pos != SL - 1;
        const int chl = cq * 256 + cg * 32 + (t & 31);
        const float tw0 = cw[chl], tw1 = cw[1536 + chl], tw2 = cw[3072 + chl], tbb = cb[chl];
#pragma unroll
        for (int e = 0; e < 32; ++e) { const int cc = cg * 32 + e, ch = cq * 256 + cc;
            const float w0 = __builtin_bit_cast(float, __builtin_amdgcn_readlane(__builtin_bit_cast(int, tw0), e)), w1 = __builtin_bit_cast(float, __builtin_amdgcn_readlane(__builtin_bit_cast(int, tw1), e));
            const float w2 = __builtin_bit_cast(float, __builtin_amdgcn_readlane(__builtin_bit_cast(int, tw2), e)), bb = __builtin_bit_cast(float, __builtin_amdgcn_readlane(__builtin_bit_cast(int, tbb), e));
            float v = bb + w1 * bf2f(raw[(t + 1) * RS + cc]);
            if (hasp) v += w0 * bf2f(raw[t * RS + cc]);
            if (hasn) v += w2 * bf2f(raw[(t + 2) * RS + cc]);
            VT[(size_t)ch * NTOK + r0 + t] = (bf16)f2bf(v); }
    }
#undef HYC_LOAD
}

__device__ __forceinline__ void xbc_conv_phase(const bf16* __restrict__ P, const float* __restrict__ cw, const float* __restrict__ cb, bf16* __restrict__ XC, int bid, int G) {
    const int tid = threadIdx.x; if (tid >= 480) return;
    const int v = tid % 96, rr = tid / 96;
    float w0[8], w1[8], w2[8], bb[8];
#pragma unroll
    for (int e = 0; e < 8; ++e) { const int ch = 8 * v + e; w0[e] = cw[ch]; w1[e] = cw[768 + ch]; w2[e] = cw[1536 + ch]; bb[e] = cb[ch]; }
    for (int it = bid; it * 5 < NTOK; it += G) { const int row = it * 5 + rr; if (row >= NTOK) break;
        const int SL = row < NCTX ? 256 : 64, pos = row & (SL - 1);
        const bf16* pp = P + (size_t)row * NPROJ + 512 + 8 * v;
        const u32x4 c = *(const u32x4*)pp; u32x4 pv = (u32x4){0u, 0u, 0u, 0u}, nx = (u32x4){0u, 0u, 0u, 0u};
        if (pos != 0) pv = *(const u32x4*)(pp - NPROJ);
        if (pos != SL - 1) nx = *(const u32x4*)(pp + NPROJ);
        float o[8];
        const unsigned cc[4] = {c.x, c.y, c.z, c.w}, pc[4] = {pv.x, pv.y, pv.z, pv.w}, nc[4] = {nx.x, nx.y, nx.z, nx.w};
#pragma unroll
        for (int e = 0; e < 8; ++e) { const int q = e >> 1; const bool hi = e & 1;
            const float xc = hi ? bf2f(cc[q] >> 16) : bf2f(cc[q] & 0xffffu), xp = hi ? bf2f(pc[q] >> 16) : bf2f(pc[q] & 0xffffu), xn = hi ? bf2f(nc[q] >> 16) : bf2f(nc[q] & 0xffffu);
            o[e] = silu_f(bb[e] + w1[e] * xc + w0[e] * xp + w2[e] * xn); }
        u32x4 w; w.x = pk2(o[0], o[1]); w.y = pk2(o[2], o[3]); w.z = pk2(o[4], o[5]); w.w = pk2(o[6], o[7]);
        *(u32x4*)(XC + (size_t)row * 768 + 8 * v) = w; }
}

constexpr int SST = 72;
__device__ __forceinline__ bf16x8 pack8(const float* o) { u32x4 w; w.x = pk2(o[0], o[1]); w.y = pk2(o[2], o[3]); w.z = pk2(o[4], o[5]); w.w = pk2(o[6], o[7]); return __builtin_bit_cast(bf16x8, w); }
__device__ __forceinline__ void ssd_chunk_phase(const Args& a, const bf16* XC, const float* DT, float* YF, float* YB, unsigned char* lds, int bid, int G) {
    const int tid = threadIdx.x, lane = tid & 63, wave = __builtin_amdgcn_readfirstlane(tid >> 6), l15 = lane & 15, g4 = lane >> 4;
    bf16* BS = (bf16*)lds;
    bf16* CS = BS + 64 * SST;
    bf16* BST = CS + 64 * SST;
    bf16* XT = BST + 64 * SST;
    bf16* XDT = XT + 64 * SST;
    bf16* XX = XDT + 64 * SST;
    bf16* S16 = XX + 64 * SST;
    float* Wv = (float*)(S16 + 64 * SST); float* DTV = Wv + 64; float* DEC = DTV + 64; float* EW = DEC + 64; float* TOT = EW + 64;
    const int nun = G == 256 ? (bid < 128 ? 1 : 2) : (384 - bid + G - 1) / G;
    const int sx = tid & 63, c8 = tid >> 6;
    for (int ui = 0; ui < nun; ++ui) {
        const int unit = G == 256 ? (bid < 128 ? bid : 128 + (bid - 128) * 2 + ui) : bid + ui * G;
        int seq, h, dir;
        if (unit < 128) { seq = 16 + (unit >> 4); h = (unit >> 1) & 7; dir = unit & 1; } else { const int u = unit - 128; seq = u >> 4; h = (u >> 1) & 7; dir = u & 1; }
        const bool lat = seq >= 16; const int L = lat ? 1024 : 256, row0 = lat ? NCTX + (seq - 16) * 1024 : seq * 256, g = h >> 2;
        const float A = -expf(a.in[17][dir * 8 + h]), dtb = a.in[16][dir * 8 + h], Dh = a.in[18][h];
        float* Yd = dir ? YB : YF;
        const int ni = wave >> 1, ph = wave & 1, ti = wave >> 1;
        f32x4 st[2];
#pragma unroll
        for (int jj = 0; jj < 2; ++jj) { const int p = 16 * (2 * ph + jj) + l15, n0 = 16 * ni + 4 * g4;
            if (lat) st[jj] = *(const f32x4*)(a.in[2] + ((size_t)(((seq - 16) * 2 + dir) * 8 + h)) * 4096 + p * 64 + n0); else st[jj] = (f32x4){0.f, 0.f, 0.f, 0.f}; }
        const int nch = L / 64;
        u32x4 pxv, pbv, pcv; float predt;
#define SSD_PREFETCH(ci_) do { const int t0p = dir ? L - ((ci_) + 1) * 64 : (ci_) * 64; const bf16* xp_ = XC + (size_t)(row0 + t0p + sx) * 768 + 8 * c8; \
            pxv = *(const u32x4*)(xp_ + h * 64); pbv = *(const u32x4*)(xp_ + 512 + g * 64); pcv = *(const u32x4*)(xp_ + 640 + g * 64); \
            predt = DT[(size_t)(row0 + t0p + lane) * 16 + dir * 8 + h]; } while (0)
        SSD_PREFETCH(0);
        for (int ci = 0; ci < nch; ++ci) {
            const int t0 = dir ? L - (ci + 1) * 64 : ci * 64;
            __syncthreads();
            if (wave == 0) {
                const float x = predt + dtb; const float dt = x > 20.f ? x : log1pf(expf(x)); float v = dt * A;
                if (dir) v = __shfl(v, 63 - lane);
#pragma unroll
                for (int off = 1; off < 64; off <<= 1) { const float u = __shfl_up(v, off); if (lane >= off) v += u; }
                const float tot = __shfl(v, 63);
                if (dir) v = __shfl(v, 63 - lane);
                DTV[lane] = dt; Wv[lane] = v; DEC[lane] = expf(tot - v); EW[lane] = expf(v); if (lane == 0) TOT[0] = expf(tot);
            }
#pragma unroll
            for (int jj = 0; jj < 2; ++jj) { const int p = 16 * (2 * ph + jj) + l15, n0 = 16 * ni + 4 * g4;
                u32x2 w; w.x = pk2(st[jj].x, st[jj].y); w.y = pk2(st[jj].z, st[jj].w); *(u32x2*)(S16 + p * SST + n0) = w; }
            *(u32x4*)(BS + sx * SST + 8 * c8) = pbv; *(u32x4*)(CS + sx * SST + 8 * c8) = pcv;
            { const unsigned bw[4] = {pbv.x, pbv.y, pbv.z, pbv.w};
#pragma unroll
              for (int e = 0; e < 8; ++e) BST[(8 * c8 + e) * SST + sx] = (bf16)((e & 1) ? (bw[e >> 1] >> 16) : (bw[e >> 1] & 0xffffu)); }
            const u32x4 xv = pxv;
            if (ci + 1 < nch) SSD_PREFETCH(ci + 1);
            __syncthreads();
            { const float dts = DTV[sx], dcs = DEC[sx]; const unsigned xw[4] = {xv.x, xv.y, xv.z, xv.w};
#pragma unroll
              for (int e = 0; e < 8; ++e) { const unsigned hb = (e & 1) ? (xw[e >> 1] >> 16) : (xw[e >> 1] & 0xffffu); const float xf = bf2f(hb), xd = xf * dts;
                  XX[(8 * c8 + e) * SST + sx] = (bf16)hb; XT[(8 * c8 + e) * SST + sx] = (bf16)f2bf(xd); XDT[(8 * c8 + e) * SST + sx] = (bf16)f2bf(xd * dcs); } }
            __syncthreads();
            const int tl = 16 * ti + l15;
            bf16x8 cfr[2];
#pragma unroll
            for (int kb = 0; kb < 2; ++kb) cfr[kb] = *(const bf16x8*)(CS + tl * SST + 32 * kb + 8 * g4);
            f32x4 gt[4]; bf16x8 afr[4][2];
#pragma unroll
            for (int si = 0; si < 4; ++si)
#pragma unroll
                for (int kb = 0; kb < 2; ++kb) afr[si][kb] = *(const bf16x8*)(BS + (16 * si + l15) * SST + 32 * kb + 8 * g4);
            u32x2 xlo[2][2], xhi[2][2]; bf16x8 s16f[2][2], bstf[2], xdtf[2][2];
#pragma unroll
            for (int jj = 0; jj < 2; ++jj) { const int pl = 16 * (2 * ph + jj) + l15;
#pragma unroll
                for (int kb = 0; kb < 2; ++kb) { xlo[jj][kb] = *(const u32x2*)(XT + pl * SST + 32 * kb + 4 * g4); xhi[jj][kb] = *(const u32x2*)(XT + pl * SST + 32 * kb + 16 + 4 * g4);
                    s16f[jj][kb] = *(const bf16x8*)(S16 + pl * SST + 32 * kb + 8 * g4); xdtf[jj][kb] = *(const bf16x8*)(XDT + pl * SST + 32 * kb + 8 * g4); } }
#pragma unroll
            for (int kb = 0; kb < 2; ++kb) bstf[kb] = *(const bf16x8*)(BST + (16 * ni + l15) * SST + 32 * kb + 8 * g4);
#pragma unroll
            for (int si = 0; si < 4; ++si) { gt[si] = (f32x4){0.f, 0.f, 0.f, 0.f};
#pragma unroll
                for (int kb = 0; kb < 2; ++kb) gt[si] = __builtin_amdgcn_mfma_f32_16x16x32_bf16(afr[si][kb], cfr[kb], gt[si], 0, 0, 0); }
            const float wt = Wv[tl], ewt = EW[tl];
            bf16x8 mfr[2], csc[2];
#pragma unroll
            for (int kb = 0; kb < 2; ++kb) { float m[8];
#pragma unroll
                for (int hh = 0; hh < 2; ++hh) { const int si = 2 * kb + hh; const f32x4 ws = *(const f32x4*)(Wv + 16 * si + 4 * g4);
#pragma unroll
                    for (int r = 0; r < 4; ++r) { const int sidx = 16 * si + 4 * g4 + r; const bool ok = dir ? (sidx >= tl) : (sidx <= tl);
                        m[4 * hh + r] = ok ? gt[si][r] * __expf(fminf(wt - ws[r], 0.f)) : 0.f; } }
                mfr[kb] = pack8(m);
                float cs[8];
#pragma unroll
                for (int j = 0; j < 8; ++j) cs[j] = bf2f((unsigned)(unsigned short)cfr[kb][j]) * ewt;
                csc[kb] = pack8(cs); }
#pragma unroll
            for (int jj = 0; jj < 2; ++jj) { const int pl = 16 * (2 * ph + jj) + l15;
                f32x4 acc = (f32x4){0.f, 0.f, 0.f, 0.f};
#pragma unroll
                for (int kb = 0; kb < 2; ++kb) { const u32x2 lo = xlo[jj][kb], hi = xhi[jj][kb];
                    const u32x4 bxw = (u32x4){lo.x, lo.y, hi.x, hi.y};
                    acc = __builtin_amdgcn_mfma_f32_16x16x32_bf16(mfr[kb], __builtin_bit_cast(bf16x8, bxw), acc, 0, 0, 0); }
#pragma unroll
                for (int kb = 0; kb < 2; ++kb) acc = __builtin_amdgcn_mfma_f32_16x16x32_bf16(csc[kb], s16f[jj][kb], acc, 0, 0, 0);
                if (dir == 0) { const u32x2 xx = *(const u32x2*)(XX + pl * SST + 16 * ti + 4 * g4);
                    acc.x += Dh * bf2f(xx.x & 0xffffu); acc.y += Dh * bf2f(xx.x >> 16); acc.z += Dh * bf2f(xx.y & 0xffffu); acc.w += Dh * bf2f(xx.y >> 16); }
                float* yp = Yd + (size_t)(row0 + t0 + 16 * ti + 4 * g4) * 512 + h * 64 + pl;
                yp[0] = acc.x; yp[512] = acc.y; yp[1024] = acc.z; yp[1536] = acc.w; }
            const float dtot = TOT[0];
#pragma unroll
            for (int jj = 0; jj < 2; ++jj) { st[jj] = st[jj] * dtot;
#pragma unroll
                for (int kb = 0; kb < 2; ++kb) st[jj] = __builtin_amdgcn_mfma_f32_16x16x32_bf16(bstf[kb], xdtf[jj][kb], st[jj], 0, 0, 0); }
        }
#undef SSD_PREFETCH
        if (!lat) {
#pragma unroll
            for (int jj = 0; jj < 2; ++jj) { const int p = 16 * (2 * ph + jj) + l15, n0 = 16 * ni + 4 * g4;
                *(f32x4*)(a.out + (size_t)NTOK * DM + ((size_t)((seq * 2 + dir) * 8 + h)) * 4096 + p * 64 + n0) = st[jj]; } }
    }
}

__device__ __forceinline__ void ssd_post_rows(const float* __restrict__ YF, const float* __restrict__ YB, const bf16* __restrict__ P, const float* __restrict__ nw, bf16* __restrict__ Y, int gw, int NGW, int lane) {
#pragma unroll 2
    for (int row = gw; row < NTOK; row += NGW) {
        const int c0 = lane * 8;
        const f32x4 f0 = *(const f32x4*)(YF + (size_t)row * 512 + c0), f1 = *(const f32x4*)(YF + (size_t)row * 512 + c0 + 4);
        const f32x4 g0 = *(const f32x4*)(YB + (size_t)row * 512 + c0), g1 = *(const f32x4*)(YB + (size_t)row * 512 + c0 + 4);
        const u32x4 zz = *(const u32x4*)(P + (size_t)row * NPROJ + c0);
        float y[8], z[8];
        z[0] = bf2f(zz.x & 0xffffu); z[1] = bf2f(zz.x >> 16); z[2] = bf2f(zz.y & 0xffffu); z[3] = bf2f(zz.y >> 16);
        z[4] = bf2f(zz.z & 0xffffu); z[5] = bf2f(zz.z >> 16); z[6] = bf2f(zz.w & 0xffffu); z[7] = bf2f(zz.w >> 16);
        y[0] = f0.x + g0.x; y[1] = f0.y + g0.y; y[2] = f0.z + g0.z; y[3] = f0.w + g0.w; y[4] = f1.x + g1.x; y[5] = f1.y + g1.y; y[6] = f1.z + g1.z; y[7] = f1.w + g1.w;
        float s = 0.f;
#pragma unroll
        for (int e = 0; e < 8; ++e) { y[e] *= silu_f(z[e]); s += y[e] * y[e]; }
        const float rstd = 1.0f / sqrtf(wave_sum(s) * (1.0f / 512.0f) + RMS_EPS);
        const f32x4 w0 = *(const f32x4*)(nw + c0), w1 = *(const f32x4*)(nw + c0 + 4);
        u32x4 o; o.x = pk2(y[0] * rstd * w0.x, y[1] * rstd * w0.y); o.y = pk2(y[2] * rstd * w0.z, y[3] * rstd * w0.w);
        o.z = pk2(y[4] * rstd * w1.x, y[5] * rstd * w1.y); o.w = pk2(y[6] * rstd * w1.z, y[7] * rstd * w1.w);
        *(u32x4*)(Y + (size_t)row * DM + c0) = o;
    }
}

template <int L, int UPI>
__device__ __forceinline__ void hyena_item(int item, const bf16* VT, const bf16* RF, const float* skip, bf16* Y, unsigned char* lds) {
    constexpr int NP = L / 32, WPU = 8 / UPI, PPW = NP / WPU, ZS = L + 56, RL = 2 * L + 32;
    bf16* Z = (bf16*)lds;
    bf16* R = Z + UPI * 8 * ZS;
    const int tid = threadIdx.x, wave = __builtin_amdgcn_readfirstlane(tid >> 6), lane = tid & 63, ul = wave / WPU, wq = wave % WPU;
    __syncthreads();
    {
        constexpr int NZ = UPI * 8 * (ZS / 8), NZT = (NZ + NTHR - 1) / NTHR, NR_ = UPI * 2 * (RL / 8), NRT = (NR_ + NTHR - 1) / NTHR;
        u32x4 zv[NZT], rv[NRT];
#pragma unroll
        for (int k = 0; k < NZT; ++k) { const int e = tid + NTHR * k; zv[k] = (u32x4){0u, 0u, 0u, 0u};
            if (e < NZ) { const int u = e / (8 * (ZS / 8)), rem = e - u * (8 * (ZS / 8)), b = rem / (ZS / 8), q = rem - b * (ZS / 8);
                const int unit = item * UPI + u, c = L == 1024 ? unit : unit >> 1, rowbase = L == 1024 ? NCTX : (unit & 1) * 2048; const int sidx = 8 * q - 16;
                if (sidx >= 0 && sidx < L) zv[k] = *(const u32x4*)(VT + (size_t)c * NTOK + rowbase + b * L + sidx); } }
#pragma unroll
        for (int k = 0; k < NRT; ++k) { const int e = tid + NTHR * k; rv[k] = (u32x4){0u, 0u, 0u, 0u};
            if (e < NR_) { const int uo = e / (RL / 8), q = e - uo * (RL / 8), u = uo >> 1, o = uo & 1;
                const int unit = item * UPI + u, c = L == 1024 ? unit : unit >> 1;
                if (8 * q < 2 * L) rv[k] = *(const u32x4*)(RF + ((size_t)o * 512 + c) * (2 * L) + 8 * q); } }
#pragma unroll
        for (int k = 0; k < NZT; ++k) { const int e = tid + NTHR * k;
            if (e < NZ) { const int u = e / (8 * (ZS / 8)), rem = e - u * (8 * (ZS / 8)), b = rem / (ZS / 8), q = rem - b * (ZS / 8); *(u32x4*)(Z + (u * 8 + b) * ZS + 8 * q) = zv[k]; } }
#pragma unroll
        for (int k = 0; k < NRT; ++k) { const int e = tid + NTHR * k;
            if (e < NR_) { const int uo = e / (RL / 8), q = e - uo * (RL / 8); *(u32x4*)(R + uo * RL + 8 * q) = rv[k]; } }
    }
    __syncthreads();
    const int unit = item * UPI + ul, c = L == 1024 ? unit : unit >> 1, rowbase = L == 1024 ? NCTX : (unit & 1) * 2048;
    const int i = lane & 15, g = lane >> 4, tau = i >> 3, b = i & 7;
    const bf16* Zp = Z + ul * 8 * ZS;
    f32x4 acc[PPW], zz1[PPW];
#pragma unroll
    for (int o = 0; o < 2; ++o) {
#pragma unroll
        for (int pp = 0; pp < PPW; ++pp) acc[pp] = (f32x4){0.f, 0.f, 0.f, 0.f};
        const bf16* Rp = R + (ul * 2 + o) * RL + L - 16 + 8 * g - i;
        const int p0 = wq * PPW;
        const bf16* Zb = Zp + b * ZS + 16 * tau + 8 * g;
#define HY_AFRAG(dl_) ((const bf16x8_u*)(Rp + 32 * (dl_)))->v
#pragma unroll 1
        for (int dl = -(p0 + PPW - 1); dl < -p0; ++dl) { const bf16x8 Af = HY_AFRAG(dl);
#pragma unroll
            for (int pp = 0; pp < PPW; ++pp) { const int m = p0 + pp + dl;
                if (m >= 0) { const bf16x8 Bf = *(const bf16x8*)(Zb + 32 * m); acc[pp] = __builtin_amdgcn_mfma_f32_16x16x32_bf16(Af, Bf, acc[pp], 0, 0, 0); } } }
        {
            const int dl0 = -p0, dl1 = NP - p0 - PPW + 1;
            bf16x8 Bf[PPW];
#pragma unroll
            for (int pp = 0; pp < PPW - 1; ++pp) Bf[pp] = *(const bf16x8*)(Zb + 32 * pp);
#pragma unroll 1
            for (int dl = dl0; dl <= dl1; dl += PPW) {
#pragma unroll
                for (int k = 0; k < PPW; ++k) {
                    if (dl + k <= dl1) {
                        Bf[(k + PPW - 1) % PPW] = *(const bf16x8*)(Zb + 32 * (p0 + dl + k + PPW - 1));
                        const bf16x8 Af = HY_AFRAG(dl + k);
#pragma unroll
                        for (int pp = 0; pp < PPW; ++pp) acc[pp] = __builtin_amdgcn_mfma_f32_16x16x32_bf16(Af, Bf[(pp + k) % PPW], acc[pp], 0, 0, 0);
                    }
                }
            }
        }
#pragma unroll 1
        for (int dl = NP - p0 - PPW + 2; dl <= NP - p0; ++dl) { const bf16x8 Af = HY_AFRAG(dl);
#pragma unroll
            for (int pp = 0; pp < PPW; ++pp) { const int m = p0 + pp + dl;
                if (m <= NP) { const bf16x8 Bf = *(const bf16x8*)(Zb + 32 * m); acc[pp] = __builtin_amdgcn_mfma_f32_16x16x32_bf16(Af, Bf, acc[pp], 0, 0, 0); } } }
#undef HY_AFRAG
        const float sk = skip[o * 512 + c];
        u32x2 gtv[PPW];
#pragma unroll
        for (int pp = 0; pp < PPW; ++pp) { const int t = 32 * (wq * PPW + pp) + 16 * tau + 4 * g; gtv[pp] = *(const u32x2*)(VT + (size_t)((o + 1) * 512 + c) * NTOK + rowbase + b * L + t); }
#pragma unroll
        for (int pp = 0; pp < PPW; ++pp) { const int t = 32 * (wq * PPW + pp) + 16 * tau + 4 * g;
            const u32x2 gt = gtv[pp];
            f32x4 prev;
            if (o == 0) { const u32x2 pz = *(const u32x2*)(Zp + b * ZS + 16 + t); prev = (f32x4){bf2f(pz.x & 0xffffu), bf2f(pz.x >> 16), bf2f(pz.y & 0xffffu), bf2f(pz.y >> 16)}; }
            else prev = zz1[pp];
            const f32x4 gate = (f32x4){bf2f(gt.x & 0xffffu), bf2f(gt.x >> 16), bf2f(gt.y & 0xffffu), bf2f(gt.y >> 16)};
            const f32x4 val = gate * (acc[pp] + prev * sk);
            if (o == 0) zz1[pp] = val;
            else { bf16* yp = Y + (size_t)(rowbase + b * L + t) * DM + 512 + c;
                yp[0] = (bf16)f2bf(val.x); yp[DM] = (bf16)f2bf(val.y); yp[2 * DM] = (bf16)f2bf(val.z); yp[3 * DM] = (bf16)f2bf(val.w); } }
        if (o == 0) {
            __syncthreads();
#pragma unroll
            for (int pp = 0; pp < PPW; ++pp) { const int t = 32 * (wq * PPW + pp) + 16 * tau + 4 * g;
                u32x2 w; w.x = pk2(zz1[pp].x, zz1[pp].y); w.y = pk2(zz1[pp].z, zz1[pp].w);
                *(u32x2*)(Z + (ul * 8 + b) * ZS + 16 + t) = w; }
            __syncthreads();
        }
    }
}

#define XB_TMO      128
#define XB_XCNT(j)  (256  + 64 * (j))
#define XB_XSUB(j)  (1280 + 64 * (j))
#define XB_XGEN(j)  (2304 + 64 * (j))
#define XB_TOP      3328
#define XB_TOPGEN   3392
#define XCD_BAR_WORDS 3456
#define XB_SPIN_CAP (1u << 18)

__device__ __forceinline__ unsigned xb_ld(unsigned* p)              { return __hip_atomic_load(p, __ATOMIC_RELAXED, __HIP_MEMORY_SCOPE_AGENT); }
__device__ __forceinline__ unsigned xb_add(unsigned* p, unsigned v) { return __hip_atomic_fetch_add(p, v, __ATOMIC_RELAXED, __HIP_MEMORY_SCOPE_AGENT); }
__device__ __forceinline__ unsigned xb_xcc_id() { return (unsigned)__builtin_amdgcn_s_getreg((3 << 11) | 20) & 0xFu; }
#define XB_SPIN(cond, bar) do { unsigned _sp = 0; while (cond) { __builtin_amdgcn_s_sleep(1); \
    if ((++_sp & 255u) == 0u) { if (xb_ld(&(bar)[XB_TMO])) break; if (_sp > XB_SPIN_CAP) { atomicAdd(&(bar)[XB_TMO], 1u); break; } } } } while (0)

struct XcdBarrier {
    unsigned* bar; unsigned x;
    volatile LAS unsigned* st;
};

__device__ __forceinline__ XcdBarrier xcd_barrier_post(unsigned* bar, volatile LAS unsigned* st) {
    XcdBarrier b; b.bar = bar; b.x = xb_xcc_id(); b.st = st;
    if (threadIdx.x == 0) (void)xb_add(&bar[XB_XCNT(b.x)], 1u);
    return b;
}
__device__ __forceinline__ void xcd_barrier_complete(unsigned* bar, unsigned x, unsigned& nloc, unsigned& nx) {
    const unsigned G = gridDim.x * gridDim.y * gridDim.z;
    unsigned sum, cnt, mine, sp = 0u;
    for (;;) {
        sum = 0u; cnt = 0u; mine = 0u;
#pragma unroll
        for (unsigned j = 0; j < 16; ++j) { const unsigned c = xb_ld(&bar[XB_XCNT(j)]); sum += c; cnt += (c > 0u) ? 1u : 0u; mine = (j == x) ? c : mine; }
        if (sum == G) break;
        __builtin_amdgcn_s_sleep(1);
        if ((++sp & 255u) == 0u) { if (xb_ld(&bar[XB_TMO])) break; if (sp > XB_SPIN_CAP) { atomicAdd(&bar[XB_TMO], 1u); break; } }
    }
    nloc = mine > 0u ? mine : 1u; nx = cnt > 0u ? cnt : 1u;
}

__device__ __forceinline__ void xcd_barrier(const XcdBarrier& b) {
    asm volatile("s_waitcnt vmcnt(0)" ::: "memory");
    __syncthreads();
    if (threadIdx.x == 0) {
        unsigned* bar = b.bar;
        __builtin_amdgcn_s_waitcnt(0);
        unsigned nloc = b.st[0], nx = b.st[1];
        if (nloc == 0u) { xcd_barrier_complete(bar, b.x, nloc, nx); b.st[0] = nloc; b.st[1] = nx; }
        const unsigned old = xb_add(&bar[XB_XSUB(b.x)], 1u);
        const unsigned gen = old / nloc;
        if (old + 1u == (gen + 1u) * nloc) {
            __builtin_amdgcn_fence(__ATOMIC_RELEASE, "agent");
            asm volatile("s_waitcnt vmcnt(0)" ::: "memory");
            const unsigned og = xb_add(&bar[XB_TOP], 1u);
            const unsigned tg = og / nx;
            if (og + 1u == (tg + 1u) * nx) xb_add(&bar[XB_TOPGEN], 1u);
            else XB_SPIN(xb_ld(&bar[XB_TOPGEN]) == tg, bar);
            __builtin_amdgcn_fence(__ATOMIC_ACQUIRE, "agent");
            xb_add(&bar[XB_XGEN(b.x)], 1u);
            asm volatile("s_waitcnt vmcnt(0)" ::: "memory");
        } else {
            XB_SPIN(xb_ld(&bar[XB_XGEN(b.x)]) == gen, bar);
            __builtin_amdgcn_fence(__ATOMIC_ACQUIRE, "agent");
            asm volatile("s_waitcnt vmcnt(0)" ::: "memory");
        }
    }
    __syncthreads();
}

#define CG_SYNC() do { asm volatile("s_waitcnt vmcnt(0)" ::: "memory"); grid.sync(); } while (0)
#define GRID_SYNC() xcd_barrier(xbar)
#ifndef REP_P0
#define REP_P0 1
#endif
#ifndef REP_P6A
#define REP_P6A 1
#endif
#ifndef REP_P6B
#define REP_P6B 1
#endif
#ifndef REP_P7
#define REP_P7 1
#endif
__global__ void __launch_bounds__(NTHR, 2) fwd_megakernel(Args a) {
    extern __shared__ __attribute__((aligned(16))) unsigned char lds[];
    cg::grid_group grid = cg::this_grid();
    const int tid = threadIdx.x, lane = tid & 63, wave = __builtin_amdgcn_readfirstlane(tid >> 6);
    const int bid = blockIdx.x, G = gridDim.x, gw = bid * NWAVES + wave, NGW = G * NWAVES;
    unsigned char* ws = a.ws;
    float* MOD = (float*)(ws + WS_MOD); float* DT = (float*)(ws + WS_DT);
    bf16* H = (bf16*)(ws + WS_H); bf16* U = (bf16*)(ws + WS_U); bf16* P = U; bf16* Y = H;
    float* X2 = (float*)(ws + WS_X2); float* YF = X2; float* YB = X2 + (size_t)NTOK * 512;
    bf16* VT = (bf16*)(ws + WS_VT);
    float* X1 = a.out;
    PG8_LAS unsigned char* ldsl = (PG8_LAS unsigned char*)lds;
    volatile LAS unsigned* xst = (volatile LAS unsigned*)((LAS unsigned char*)lds + 131072 + 64);
    if (tid < 2) xst[tid] = 0u;
    __syncthreads();
    const XcdBarrier xbar = xcd_barrier_post((unsigned*)ws, xst);

    const bool defer = (G == 256);
    ada_phase(a.in[3], a.in[4], a.in[5], a.in[6], MOD, lds, bid, G);
    __syncthreads();
    transpose_phase(a, lds, (G - 1 - bid) * NWAVES + wave, NGW, wave, lane, defer ? 0 : 2);
    __syncthreads();
    if (!defer) { filter_phase(a, lds, bid, G); __syncthreads(); }
    if (G > (1 << 30)) grid.sync();
    GRID_SYNC();
    norm_rows<0>(a.in[0], a.in[1], a.in[7], MOD, 0 * DM, 1 * DM, H, nullptr, gw, NGW, lane);
    GRID_SYNC();
    { pg8::Gemm g{H, (const bf16*)(ws + WS_WB1), NTOK, 2 * FFP, DM}; pg8::StaticOrder S; S.init(NTOK, 2 * FFP, G, bid);
      pg8::EpiSwiGLU E{U, FFP}; pg8::gemm_phase<pg8::EpiSwiGLU, pg8::StaticOrder, true, true>(ldsl, g, S, E); }
    if (defer && bid >= 32) transpose_phase(a, lds, (bid - 32) * NWAVES + wave, 224 * NWAVES, wave, lane, 3);
    GRID_SYNC();
    { pg8::Gemm g{U, (const bf16*)(ws + WS_WD1), NTOK, DM, FFP}; pg8::StaticOrder S; S.init(NTOK, DM, G, bid);
      pg8::EpiResid E{a.in[0], a.in[1], X1, MOD + 2 * DM, 0.5f}; pg8::gemm_phase<pg8::EpiResid, pg8::StaticOrder, true, true>(ldsl, g, S, E); }
    if (defer && bid >= 192) { transpose_phase(a, lds, (bid - 192) * NWAVES + wave, 64 * NWAVES, wave, lane, 1); filter_h2_phase(a, (float*)(ws + WS_H2G), lds, bid - 192, 64); }
    GRID_SYNC();
    norm_rows<0>(X1, X1 + (size_t)NCTX * DM, a.in[11], MOD, 3 * DM, 4 * DM, H, nullptr, gw, NGW, lane);
    GRID_SYNC();
    { pg8::Gemm g{H, (const bf16*)(ws + WS_WIN), NTOK, NPROJ, DM}; pg8::StaticOrder S; S.init(NTOK, NPROJ, G, bid);
      pg8::EpiProj E{P, DT}; pg8::gemm_phase<pg8::EpiProj, pg8::StaticOrder, true, true>(ldsl, g, S, E); }
    if (defer && bid >= 64) { if (bid < 192) filter_out_phase(a, (const float*)(ws + WS_H2G), lds, bid - 64); __syncthreads(); transpose_phase(a, lds, (bid - 64) * NWAVES + wave, 192 * NWAVES, wave, lane, 4); }
    GRID_SYNC();
    hyconv_phase(P, a.in[20], a.in[21], VT, lds, bid, G);
    xbc_conv_phase(P, a.in[14], a.in[15], (bf16*)(ws + WS_XC), bid, G);
    GRID_SYNC();
    ssd_chunk_phase(a, (const bf16*)(ws + WS_XC), DT, YF, YB, lds, bid, G);
    for (int item = bid; item < 256 + 256; item += G) {
        const int it = item & 255, cp = (G == 256) ? ((it & 7) * 32 + (it >> 3)) : it;
        if (item < 256) hyena_item<1024, 2>(cp, VT, (const bf16*)(ws + WS_RF1), a.in[28], Y, lds);
    }
    if (G == 256) { if (bid >= 128) { const int cq = (bid & 7) * 16 + ((bid - 128) >> 3); hyena_item<256, 8>(cq, VT, (const bf16*)(ws + WS_RF0), a.in[28], Y, lds); } }
    else for (int item = bid; item < 128; item += G) hyena_item<256, 8>(item, VT, (const bf16*)(ws + WS_RF0), a.in[28], Y, lds);
    GRID_SYNC();
    ssd_post_rows(YF, YB, P, a.in[19], Y, gw, NGW, lane);
    GRID_SYNC();
    { pg8::Gemm g{Y, (const bf16*)(ws + WS_WOUT), NTOK, DM, DM}; pg8::StaticOrder S; S.init(NTOK, DM, G, bid);
      pg8::EpiResid E{X1, X1 + (size_t)NCTX * DM, X2, MOD + 5 * DM, 1.0f}; pg8::gemm_phase<pg8::EpiResid, pg8::StaticOrder, true, true>(ldsl, g, S, E); }
    if (defer && bid >= 192) transpose_phase(a, lds, (bid - 192) * NWAVES + wave, 64 * NWAVES, wave, lane, 5);
    GRID_SYNC();
    norm_rows<0>(X2, X2 + (size_t)NCTX * DM, a.in[29], MOD, 6 * DM, 7 * DM, H, nullptr, gw, NGW, lane);
    GRID_SYNC();
    { pg8::Gemm g{H, (const bf16*)(ws + WS_WB2), NTOK, 2 * FFP, DM}; pg8::StaticOrder S; S.init(NTOK, 2 * FFP, G, bid);
      pg8::EpiSwiGLU E{U, FFP}; pg8::gemm_phase<pg8::EpiSwiGLU, pg8::StaticOrder, true, true>(ldsl, g, S, E); }
    GRID_SYNC();
    { pg8::Gemm g{U, (const bf16*)(ws + WS_WD2), NTOK, DM, FFP}; pg8::StaticOrder S; S.init(NTOK, DM, G, bid);
      pg8::EpiResid E{X2, X2 + (size_t)NCTX * DM, a.out, MOD + 8 * DM, 0.5f}; pg8::gemm_phase<pg8::EpiResid, pg8::StaticOrder, true, true>(ldsl, g, S, E); }
    GRID_SYNC();
    norm_rows<1>(a.out, a.out + (size_t)NCTX * DM, a.in[33], nullptr, 0, 0, nullptr, a.out, gw, NGW, lane);
}

extern "C" void kernel_launch(void* const* d_in, const int* in_sizes, int n_in, void* d_out, int out_size, void* d_ws, size_t ws_size, hipStream_t stream) {
    static int grid = 0;
    if (grid == 0) {
        if (n_in != 34 || ws_size < WS_END) { fprintf(stderr, "kernel_launch: expected 34 inputs and >= %zu bytes of workspace; got %d, %zu\n", (size_t)WS_END, n_in, ws_size); grid = -1; return; }
        int dev = 0, cus = 0, per_cu = 0;
        (void)hipGetDevice(&dev);
        (void)hipDeviceGetAttribute(&cus, hipDeviceAttributeMultiprocessorCount, dev);
        if (hipFuncSetAttribute((const void*)fwd_megakernel, hipFuncAttributeMaxDynamicSharedMemorySize, LDS_BYTES) != hipSuccess) fprintf(stderr, "kernel_launch: hipFuncSetAttribute failed\n");
        if (hipOccupancyMaxActiveBlocksPerMultiprocessor(&per_cu, (const void*)fwd_megakernel, NTHR, LDS_BYTES) != hipSuccess || per_cu < 1) { fprintf(stderr, "kernel_launch: occupancy query gave %d\n", per_cu); per_cu = 1; }
        (void)hipGetLastError();
        if (cus <= 0) cus = 256;
        grid = cus * (per_cu > 1 ? 1 : per_cu);
        if (grid < 144) fprintf(stderr, "kernel_launch: grid %d < 144\n", grid);
    }
    if (grid < 0) return;
    if (hipMemsetAsync(d_ws, 0, 16384, stream) != hipSuccess) { fprintf(stderr, "kernel_launch: memset failed\n"); return; }
    Args a{};
    for (int i = 0; i < 34; ++i) a.in[i] = (const float*)d_in[i];
    a.out = (float*)d_out; a.ws = (unsigned char*)d_ws;
    void* args[] = {&a};
    hipError_t e = hipLaunchCooperativeKernel((const void*)fwd_megakernel, dim3(grid), dim3(NTHR), args, LDS_BYTES, stream);
    if (e != hipSuccess) fprintf(stderr, "cooperative launch failed: %s (grid %d)\n", hipGetErrorString(e), grid);
}
```

```cpp
#include <hip/hip_runtime.h>
#include <hip/hip_cooperative_groups.h>
#include <cstdio>
#include <cstdint>
namespace cg = cooperative_groups;

namespace pg8 {
#define PG8_LAS __attribute__((address_space(3)))
typedef unsigned short bf16_t;
typedef short bf16x8 __attribute__((ext_vector_type(8)));
typedef float f32x4 __attribute__((ext_vector_type(4)));
typedef unsigned u32x4 __attribute__((ext_vector_type(4)));
constexpr int BM = 256, BK = 64, HALF = 128, HTB = HALF * BK * 2  , STAGE_BYTES = 8 * HTB, NXCD = 8, WGM = 8;

__host__ __device__ __forceinline__ int lds_byte(int r, int c) { const int st = (r >> 4) * 2 + (c >> 5), rr = r & 15, cc = c & 31, ob = rr * 64 + cc * 2; return st * 1024 + (ob ^ (((ob >> 9) & 1) << 5)); }
__host__ __device__ __forceinline__ void stage_rc(int b, int& R, int& C) { const int st = b / 1024, sb = b % 1024, swz = sb ^ (((sb >> 9) & 1) << 5); R = (st >> 1) * 16 + swz / 64; C = (st & 1) * 32 + (swz % 64) / 2; }
__host__ __device__ __forceinline__ int perm32(int rho) { const int n = rho >> 4, i = rho & 15; return 8 * (i >> 2) + 4 * n + (i & 3); }

struct Unit { int pm, pn; };
struct Gemm { const bf16_t* A; const bf16_t* Bt; int M, N, K; };

struct StaticOrder {
    int nM, nN, nwg, G, c;
    __host__ __device__ void init(int M, int N, int G_, int c_) { nM = M / BM; nN = N / BM; nwg = nM * nN; G = G_; c = c_; }
    __host__ __device__ bool next(int i, Unit& u) const {
        const long L = (long)i * G + c; if (L >= nwg) return false;
        int wgid = (int)L; { const int q = nwg / NXCD, r = nwg % NXCD, xcd = wgid % NXCD, off = wgid / NXCD; wgid = (xcd < r ? xcd * (q + 1) : r * (q + 1) + (xcd - r) * q) + off; }
        const int nig = WGM * nN, gid = wgid / nig, fm = gid * WGM, gsz = (nM - fm) < WGM ? (nM - fm) : WGM;
        u.pm = fm + ((wgid % nig) % gsz); u.pn = (wgid % nig) / gsz; return true;
    }
    __device__ __forceinline__ void a_ready(const Unit&) const {}
    __device__ __forceinline__ void done(const Unit&) const {}
};

__device__ __forceinline__ unsigned cvt_pk_bf16(float lo, float hi) { unsigned r; asm volatile("v_cvt_pk_bf16_f32 %0, %1, %2" : "=v"(r) : "v"(lo), "v"(hi)); return r; }
__device__ __forceinline__ float silu_fast(float x) { return x * __builtin_amdgcn_rcpf(1.0f + __builtin_amdgcn_exp2f(-1.4426950408889634f * x)); }

struct EpiSwiGLU {
    static constexpr bool PERM = true, AFTER_DRAIN = false;
    bf16_t* O; int ldc;
    __device__ __forceinline__ void operator()(const f32x4 (&acc)[2][2][4][2], const Unit& u, int wr, int wc, int fr, int fq) const {
        const int row0 = u.pm * BM + wr * 64 + fr, col0 = u.pn * HALF + wc * 32 + 8 * fq;
#pragma unroll
        for (int ai = 0; ai < 2; ++ai)
#pragma unroll
            for (int m = 0; m < 4; ++m) { bf16_t* rowp = O + (size_t)(row0 + ai * HALF + m * 16) * ldc + col0;
                const f32x4 g0 = acc[ai][0][m][0], g1 = acc[ai][0][m][1], u0 = acc[ai][1][m][0], u1 = acc[ai][1][m][1];
                u32x4 w; w.x = cvt_pk_bf16(silu_fast(g0[0]) * u0[0], silu_fast(g0[1]) * u0[1]); w.y = cvt_pk_bf16(silu_fast(g0[2]) * u0[2], silu_fast(g0[3]) * u0[3]);
                w.z = cvt_pk_bf16(silu_fast(g1[0]) * u1[0], silu_fast(g1[1]) * u1[1]); w.w = cvt_pk_bf16(silu_fast(g1[2]) * u1[2], silu_fast(g1[3]) * u1[3]);
                *(u32x4*)rowp = w; }
    }
};
struct EpiResid {
    static constexpr bool PERM = false, AFTER_DRAIN = false;
    const float* base0; const float* base1; float* out; const float* gmod; float scale;
    __device__ __forceinline__ void operator()(const f32x4 (&acc)[2][2][4][2], const Unit& u, int wr, int wc, int fr, int fq) const {
        const int row0 = u.pm * BM + wr * 64 + fr, col0 = u.pn * BM + wc * 32 + 4 * fq;
        const bool ctx = u.pm < 16; const int modrow = ctx ? 8 : ((u.pm - 16) >> 2);
        const float* bp = ctx ? base0 : base1 - (size_t)4096 * 1024;
        const float* gp = gmod + (size_t)modrow * 9216 + col0;
        f32x4 gv[2][2];
#pragma unroll
        for (int bj = 0; bj < 2; ++bj)
#pragma unroll
            for (int n = 0; n < 2; ++n) gv[bj][n] = *(const f32x4*)(gp + bj * HALF + n * 16) * scale;
#pragma unroll
        for (int ai = 0; ai < 2; ++ai)
#pragma unroll
            for (int m = 0; m < 4; ++m) { const size_t off = (size_t)(row0 + ai * HALF + m * 16) * 1024 + col0;
#pragma unroll
                for (int bj = 0; bj < 2; ++bj)
#pragma unroll
                    for (int n = 0; n < 2; ++n) { const f32x4 b = *(const f32x4*)(bp + off + bj * HALF + n * 16); *(f32x4*)(out + off + bj * HALF + n * 16) = b + gv[bj][n] * acc[ai][bj][m][n]; } }
    }
};
struct EpiProj {
    static constexpr bool PERM = true, AFTER_DRAIN = false;
    bf16_t* P; float* DT;
    __device__ __forceinline__ void operator()(const f32x4 (&acc)[2][2][4][2], const Unit& u, int wr, int wc, int fr, int fq) const {
        const int row0 = u.pm * BM + wr * 64 + fr;
        if (u.pn < 11) {
            const int col0 = u.pn * BM + wc * 32 + 8 * fq;
#pragma unroll
            for (int ai = 0; ai < 2; ++ai)
#pragma unroll
                for (int m = 0; m < 4; ++m) { bf16_t* rowp = P + (size_t)(row0 + ai * HALF + m * 16) * 3072 + col0;
#pragma unroll
                    for (int bj = 0; bj < 2; ++bj) { const f32x4 v0 = acc[ai][bj][m][0], v1 = acc[ai][bj][m][1];
                        u32x4 w; w.x = cvt_pk_bf16(v0[0], v0[1]); w.y = cvt_pk_bf16(v0[2], v0[3]); w.z = cvt_pk_bf16(v1[0], v1[1]); w.w = cvt_pk_bf16(v1[2], v1[3]);
                        *(u32x4*)(rowp + bj * HALF) = w; } }
        } else if (wc == 0 && fq < 2) {
#pragma unroll
            for (int ai = 0; ai < 2; ++ai)
#pragma unroll
                for (int m = 0; m < 4; ++m) { float* rowp = DT + (size_t)(row0 + ai * HALF + m * 16) * 16 + 8 * fq;
                    *(f32x4*)(rowp) = acc[ai][0][m][0]; *(f32x4*)(rowp + 4) = acc[ai][0][m][1]; }
        }
    }
};

template <class Epi, class Sched, bool ALIGN_EPI = false, bool SP2 = false>
__device__ __forceinline__ void gemm_phase(PG8_LAS unsigned char* lds, const Gemm g, const Sched& S, const Epi& E) {
    int tid_ = threadIdx.x; asm volatile("" : "+v"(tid_));
    const int tid = tid_, wid = __builtin_amdgcn_readfirstlane(tid >> 6), lane = tid & 63, wr = wid >> 2, wc = wid & 3, fr = lane & 15, fq = lane >> 4;
    const int K = g.K, nt = K / BK;
    unsigned voffA[2], voffB[2];
#pragma unroll
    for (int i = 0; i < 2; ++i) { int R, C; stage_rc(tid * 16 + i * 8192, R, C); const int Rb = Epi::PERM ? ((R & ~31) + perm32(R & 31)) : R;
        voffA[i] = (unsigned)(R * K + C) * 2u; voffB[i] = (unsigned)(Rb * K + C) * 2u; }
    const size_t kstep = (size_t)(BK * 2);
    const size_t hstep = (size_t)HALF * K * 2;
    const size_t tstep = 2 * hstep;
    const unsigned ldsw = (unsigned)wid * 1024u;
    const int aoff = lds_byte(wr * 64 + fr, fq * 8), boff = lds_byte(wc * 32 + fr, fq * 8);
#define PG8_SA(b, h) (((b) * 2 + (h)) * HTB)
#define PG8_SB(b, h) ((4 + (b) * 2 + (h)) * HTB)
#define PG8_STAGE(bufoff, gbase, voff) do { _Pragma("unroll") for (int _i = 0; _i < 2; ++_i) \
        __builtin_amdgcn_global_load_lds((const unsigned*)((const char*)(gbase) + (voff)[_i]), (PG8_LAS unsigned*)(lds + (bufoff) + ldsw + _i * 8192), 16, 0, 0); } while (0)
#define PG8_LDA(dst, b, h) do { _Pragma("unroll") for (int m = 0; m < 4; ++m) _Pragma("unroll") for (int k = 0; k < 2; ++k) dst[m][k] = *(const PG8_LAS bf16x8*)(lds + PG8_SA(b, h) + aoff + m * 2048 + k * 1024); } while (0)
#define PG8_LDB(dst, b, h) do { _Pragma("unroll") for (int n = 0; n < 2; ++n) _Pragma("unroll") for (int k = 0; k < 2; ++k) dst[n][k] = *(const PG8_LAS bf16x8*)(lds + PG8_SB(b, h) + boff + n * 2048 + k * 1024); } while (0)
#define PG8_MMA(ai, bj, At, Bt) do { __builtin_amdgcn_s_setprio(1); _Pragma("unroll") for (int m = 0; m < 4; ++m) _Pragma("unroll") for (int n = 0; n < 2; ++n) _Pragma("unroll") for (int k = 0; k < 2; ++k) \
        acc[ai][bj][m][n] = __builtin_amdgcn_mfma_f32_16x16x32_bf16(Bt[n][k], At[m][k], acc[ai][bj][m][n], 0, 0, 0); __builtin_amdgcn_s_setprio(0); } while (0)
#define PG8_WAIT_V(n) asm volatile("s_waitcnt vmcnt(" #n ")" ::: "memory")
#define PG8_WAIT_L(n) asm volatile("s_waitcnt lgkmcnt(" #n ")" ::: "memory")
#define PG8_BAR __builtin_amdgcn_s_barrier()
#define PG8_SCHED __builtin_amdgcn_sched_barrier(0)
    Unit cur, nxt; int ui = 0;
    if (!S.next(0, cur)) return;
    f32x4 acc[2][2][4][2];
#pragma unroll
    for (int a = 0; a < 2; ++a)
#pragma unroll
        for (int b = 0; b < 2; ++b)
#pragma unroll
            for (int m = 0; m < 4; ++m)
#pragma unroll
                for (int n = 0; n < 2; ++n) acc[a][b][m][n] = (f32x4){0.f, 0.f, 0.f, 0.f};
    bf16x8 At[4][2], B0[2][2], B1[2][2];
    const char* cA = (const char*)g.A + (size_t)cur.pm * tstep; const char* cB = (const char*)g.Bt + (size_t)cur.pn * tstep;
    S.a_ready(cur);
    if constexpr (SP2) {
        PG8_STAGE(PG8_SB(0, 0), cB, voffB); PG8_STAGE(PG8_SB(0, 1), cB + hstep, voffB); PG8_STAGE(PG8_SA(0, 0), cA, voffA); PG8_STAGE(PG8_SA(0, 1), cA + hstep, voffA);
        if (wr == 1) PG8_BAR;
        PG8_WAIT_V(2); PG8_BAR;
        PG8_STAGE(PG8_SB(1, 0), cB + kstep, voffB); PG8_STAGE(PG8_SA(1, 0), cA + kstep, voffA); PG8_STAGE(PG8_SB(1, 1), cB + hstep + kstep, voffB);
        PG8_WAIT_V(6); PG8_BAR;
    } else {
        PG8_STAGE(PG8_SB(0, 0), cB, voffB); PG8_STAGE(PG8_SA(0, 0), cA, voffA); PG8_STAGE(PG8_SB(0, 1), cB + hstep, voffB); PG8_STAGE(PG8_SA(0, 1), cA + hstep, voffA);
        if (wr == 1) PG8_BAR;
        PG8_WAIT_V(4); PG8_BAR;
        PG8_STAGE(PG8_SB(1, 0), cB + kstep, voffB); PG8_STAGE(PG8_SA(1, 0), cA + kstep, voffA); PG8_STAGE(PG8_SB(1, 1), cB + hstep + kstep, voffB);
        PG8_WAIT_V(6); PG8_BAR;
    }
    for (;;) {
        const bool has_next = S.next(ui + 1, nxt);
        const char* nA = has_next ? (const char*)g.A + (size_t)nxt.pm * tstep : cA; const char* nB = has_next ? (const char*)g.Bt + (size_t)nxt.pn * tstep : cB;
        for (int t = 0; t < nt; t += 2) {
            const bool last = (t == nt - 2);
            const char* a1 = cA + (size_t)(t + 1) * kstep;
            const char* a2 = last ? nA : cA + (size_t)(t + 2) * kstep; const char* b2 = last ? nB : cB + (size_t)(t + 2) * kstep;
            const char* a3 = a2 + kstep; const char* b3 = b2 + kstep;
            if (last && has_next) S.a_ready(nxt);
            if constexpr (SP2) {
            PG8_LDB(B0, 0, 0); PG8_LDB(B1, 0, 1); PG8_SCHED; PG8_LDA(At, 0, 0); PG8_STAGE(PG8_SA(1, 1), a1 + hstep, voffA);
            PG8_WAIT_V(8); PG8_WAIT_L(0); PG8_BAR; PG8_MMA(0, 0, At, B0); PG8_MMA(0, 1, At, B1); PG8_BAR; PG8_SCHED;
            PG8_LDA(At, 0, 1); PG8_STAGE(PG8_SB(0, 0), b2, voffB); PG8_STAGE(PG8_SB(0, 1), b2 + hstep, voffB); PG8_STAGE(PG8_SA(0, 0), a2, voffA);
            PG8_WAIT_V(8); PG8_WAIT_L(0); PG8_BAR; PG8_MMA(1, 0, At, B0); PG8_MMA(1, 1, At, B1); PG8_BAR; PG8_SCHED;
            PG8_LDB(B0, 1, 0); PG8_LDB(B1, 1, 1); PG8_SCHED; PG8_LDA(At, 1, 0); PG8_STAGE(PG8_SA(0, 1), a2 + hstep, voffA);
            PG8_WAIT_V(8); PG8_WAIT_L(0); PG8_BAR; PG8_MMA(0, 0, At, B0); PG8_MMA(0, 1, At, B1); PG8_BAR; PG8_SCHED;
            PG8_LDA(At, 1, 1); PG8_STAGE(PG8_SB(1, 0), b3, voffB); PG8_STAGE(PG8_SB(1, 1), b3 + hstep, voffB); PG8_STAGE(PG8_SA(1, 0), a3, voffA);
            PG8_WAIT_V(8); PG8_WAIT_L(0); PG8_BAR; PG8_MMA(1, 0, At, B0); PG8_MMA(1, 1, At, B1); PG8_BAR; PG8_SCHED;
            } else {
            PG8_LDB(B0, 0, 0); PG8_SCHED; PG8_LDA(At, 0, 0); PG8_STAGE(PG8_SA(1, 1), a1 + hstep, voffA);
            PG8_WAIT_L(8); PG8_BAR; PG8_WAIT_L(0); PG8_MMA(0, 0, At, B0); PG8_BAR; PG8_SCHED;
            PG8_LDB(B1, 0, 1); PG8_STAGE(PG8_SB(0, 0), b2, voffB);
            PG8_BAR; PG8_WAIT_L(0); PG8_MMA(0, 1, At, B1); PG8_BAR;
            PG8_LDA(At, 0, 1); PG8_STAGE(PG8_SA(0, 0), a2, voffA);
            PG8_BAR; PG8_WAIT_L(0); PG8_MMA(1, 0, At, B0); PG8_BAR; PG8_SCHED;
            PG8_STAGE(PG8_SB(0, 1), b2 + hstep, voffB);
            PG8_WAIT_V(6); PG8_BAR; PG8_MMA(1, 1, At, B1); PG8_BAR;
            PG8_LDB(B0, 1, 0); PG8_SCHED; PG8_LDA(At, 1, 0); PG8_STAGE(PG8_SA(0, 1), a2 + hstep, voffA);
            PG8_WAIT_L(8); PG8_BAR; PG8_WAIT_L(0); PG8_MMA(0, 0, At, B0); PG8_BAR; PG8_SCHED;
            PG8_LDB(B1, 1, 1); PG8_STAGE(PG8_SB(1, 0), b3, voffB);
            PG8_BAR; PG8_WAIT_L(0); PG8_MMA(0, 1, At, B1); PG8_BAR;
            PG8_LDA(At, 1, 1); PG8_STAGE(PG8_SA(1, 0), a3, voffA);
            PG8_BAR; PG8_WAIT_L(0); PG8_MMA(1, 0, At, B0); PG8_BAR; PG8_SCHED;
            PG8_STAGE(PG8_SB(1, 1), b3 + hstep, voffB);
            PG8_WAIT_V(6); PG8_BAR; PG8_MMA(1, 1, At, B1); PG8_BAR;
            }
        }
        if constexpr (ALIGN_EPI) { if (wr == 0) PG8_BAR; }
        if constexpr (!Epi::AFTER_DRAIN) { E(acc, cur, wr, wc, fr, fq); S.done(cur); }
        if (!has_next) break;
#pragma unroll
        for (int a = 0; a < 2; ++a)
#pragma unroll
            for (int b = 0; b < 2; ++b)
#pragma unroll
                for (int m = 0; m < 4; ++m)
#pragma unroll
                    for (int n = 0; n < 2; ++n) acc[a][b][m][n] = (f32x4){0.f, 0.f, 0.f, 0.f};
        cur = nxt; cA = nA; cB = nB; ++ui;
        if constexpr (ALIGN_EPI) { if (wr == 1) PG8_BAR; }
    }
    PG8_WAIT_V(0);
    if constexpr (!ALIGN_EPI) { if (wr == 0) PG8_BAR; }
    PG8_BAR;
    if constexpr (Epi::AFTER_DRAIN) { E.fused(acc, cur, wr, wc, fr, fq, lds, wid, lane); S.done(cur); }
#undef PG8_SA
#undef PG8_SB
#undef PG8_STAGE
#undef PG8_LDA
#undef PG8_LDB
#undef PG8_MMA
#undef PG8_WAIT_V
#undef PG8_WAIT_L
#undef PG8_BAR
#undef PG8_SCHED
}
}

#define LAS __attribute__((address_space(3)))
typedef unsigned short bf16;
typedef float f32x4 __attribute__((ext_vector_type(4)));
typedef unsigned u32x4 __attribute__((ext_vector_type(4)));
typedef unsigned u32x2 __attribute__((ext_vector_type(2)));
typedef short bf16x8 __attribute__((ext_vector_type(8)));
struct __attribute__((packed, aligned(2))) bf16x8_u { bf16x8 v; };

constexpr int DM = 1024, NTOK = 12288, NCTX = 4096, FF = 2752, FFP = 2816, NPROJ = 3072, MODW = 9216, INC = 2832;
constexpr float RMS_EPS = 1e-6f;
constexpr int NTHR = 512, NWAVES = 8;
constexpr int LDS_BYTES = 132096;
constexpr size_t MiB = 1u << 20;
constexpr size_t WS_MOD = 1 * MiB, WS_DT = 2 * MiB, WS_RF0 = 3 * MiB, WS_RF1 = 4 * MiB;
constexpr size_t WS_WB1 = 8 * MiB, WS_WD1 = 19 * MiB, WS_WB2 = 25 * MiB, WS_WD2 = 36 * MiB, WS_WIN = 42 * MiB, WS_WOUT = 48 * MiB;
constexpr size_t WS_H = 50 * MiB;
constexpr size_t WS_U = 74 * MiB;
constexpr size_t WS_X2 = 146 * MiB;
constexpr size_t WS_VT = 194 * MiB;
constexpr size_t WS_XC = 231 * MiB;
constexpr size_t WS_H2G = 250 * MiB;
constexpr size_t WS_END = 251 * MiB;

struct Args { const float* in[34]; float* out; unsigned char* ws; };

__device__ __forceinline__ unsigned pk2(float lo, float hi) { unsigned r; asm("v_cvt_pk_bf16_f32 %0, %1, %2" : "=v"(r) : "v"(lo), "v"(hi)); return r; }
__device__ __forceinline__ unsigned f2bf(float f) { return pk2(f, 0.f) & 0xffffu; }
__device__ __forceinline__ float bf2f(unsigned b) { return __uint_as_float(b << 16); }
__device__ __forceinline__ float silu_f(float x) { return x * __builtin_amdgcn_rcpf(1.0f + __builtin_amdgcn_exp2f(-1.4426950408889634f * x)); }
__device__ __forceinline__ float wave_sum(float v) {
#pragma unroll
    for (int o = 1; o < 64; o <<= 1) v += __shfl_xor(v, o);
    return v;
}
#define LDS_WAIT() asm volatile("s_waitcnt lgkmcnt(0)" ::: "memory")

__device__ __forceinline__ void ada_phase(const float* c, const float* c_ctx, const float* w_ada, const float* b_ada, float* MOD, unsigned char* lds, int bid, int G) {
    const int tid = threadIdx.x;
    float* sc = (float*)lds; float* red = sc + 9 * 1024;
    if (bid >= 288) return;
    for (int e = tid; e < 9 * 1024; e += NTHR) { const int r = e >> 10, k = e & 1023; const float cv = r < 8 ? c[r * 1024 + k] : c_ctx[k]; sc[e] = silu_f(cv); }
    __syncthreads();
    for (int item = bid; item < 288; item += G) {
        const int col0 = item * 32, cq = tid & 7, ks = tid >> 3;
        f32x4 acc[9];
#pragma unroll
        for (int r = 0; r < 9; ++r) acc[r] = (f32x4){0.f, 0.f, 0.f, 0.f};
        const float* wp = w_ada + (size_t)(ks * 16) * MODW + col0 + 4 * cq;
        f32x4 w[16];
#pragma unroll
        for (int kk = 0; kk < 16; ++kk) w[kk] = *(const f32x4*)(wp + (size_t)kk * MODW);
#pragma unroll
        for (int kk = 0; kk < 16; ++kk) {
#pragma unroll
            for (int r = 0; r < 9; ++r) acc[r] += sc[r * 1024 + ks * 16 + kk] * w[kk]; }
#pragma unroll
        for (int r = 0; r < 9; ++r) *(f32x4*)(red + (ks * 9 + r) * 32 + 4 * cq) = acc[r];
        __syncthreads();
        if (tid < 288) { const int r = tid >> 5, col = tid & 31; float sum = b_ada[col0 + col];
            for (int k2 = 0; k2 < 64; ++k2) sum += red[(k2 * 9 + r) * 32 + col];
            MOD[r * MODW + col0 + col] = sum; }
        __syncthreads();
    }
}

struct TrItem { const float* W; bf16* dst; int ldw, kvalid, srccol4, Kdst, drow0, k0; };
constexpr int TR_I_WB = 16 * 176, TR_I_WD = 44 * 32, TR_I_WIN = 16 * 96, TR_I_WOUT = 16 * 32, TR_NITEMS = 2 * TR_I_WB + 2 * TR_I_WD + TR_I_WIN + TR_I_WOUT;
__device__ __forceinline__ TrItem tr_item(const Args& a, int r, int lane) {
    unsigned char* ws = a.ws; const int q4 = 4 * (lane & 7); TrItem t;
    if (r < 2 * TR_I_WB) { const int f = r / TR_I_WB; r -= f * TR_I_WB; const int kb = r / 176, nb = r % 176, n = nb * 32 + q4;
        const int pn = n >> 8, w = n & 255, bj = w >> 7, col = pn * 128 + (w & 127);
        t.W = bj ? a.in[f ? 31 : 9] : a.in[f ? 30 : 8]; t.ldw = FF; t.kvalid = 1024; t.srccol4 = col < FF ? col : -1; t.dst = (bf16*)(ws + (f ? WS_WB2 : WS_WB1)); t.Kdst = 1024; t.drow0 = nb * 32; t.k0 = kb * 64; return t; }
    r -= 2 * TR_I_WB;
    if (r < 2 * TR_I_WD) { const int f = r / TR_I_WD; r -= f * TR_I_WD; const int kb = r / 32, nb = r % 32;
        t.W = a.in[f ? 32 : 10]; t.ldw = 1024; t.kvalid = FF; t.srccol4 = nb * 32 + q4; t.dst = (bf16*)(ws + (f ? WS_WD2 : WS_WD1)); t.Kdst = FFP; t.drow0 = nb * 32; t.k0 = kb * 64; return t; }
    r -= 2 * TR_I_WD;
    if (r < TR_I_WIN) { const int kb = r / 96, nb = r % 96, n = nb * 32 + q4;
        t.W = a.in[12]; t.ldw = INC; t.kvalid = 1024; t.srccol4 = n < 1280 ? n : (n < 2816 ? n + 16 : (n < 2832 ? n - 1536 : -1)); t.dst = (bf16*)(ws + WS_WIN); t.Kdst = 1024; t.drow0 = nb * 32; t.k0 = kb * 64; return t; }
    r -= TR_I_WIN;
    { const int kb = r / 32, nb = r % 32;
        t.W = a.in[13]; t.ldw = 1024; t.kvalid = 1024; t.srccol4 = nb * 32 + q4; t.dst = (bf16*)(ws + WS_WOUT); t.Kdst = 1024; t.drow0 = nb * 32; t.k0 = kb * 64; return t; }
}
__device__ __forceinline__ int tr_nitems(int set) { return set == 2 ? TR_NITEMS : (set == 0 ? TR_I_WB : (set == 1 ? TR_I_WD : (set == 3 ? TR_I_WD + TR_I_WIN + TR_I_WOUT : TR_I_WB / 2))); }
__device__ __forceinline__ int tr_canon(int set, int i) {
    if (set == 2 || set == 0) return i;
    if (set == 1) return 2 * TR_I_WB + TR_I_WD + i;
    if (set == 4) return TR_I_WB + i;
    if (set == 5) return TR_I_WB + TR_I_WB / 2 + i;
    if (i < TR_I_WD) return 2 * TR_I_WB + i;
    return 2 * TR_I_WB + 2 * TR_I_WD + (i - TR_I_WD);
}
__device__ __forceinline__ void transpose_phase(const Args& a, unsigned char* lds, int gw, int NGW, int wave, int lane, int set) {
    float* scr = (float*)(lds + wave * 16384);
    const int nit = tr_nitems(set);
    if (gw >= nit) return;
    f32x4 v[8]; TrItem cur = tr_item(a, tr_canon(set, gw), lane);
#define TR_LOAD(t_) do { _Pragma("unroll") for (int i = 0; i < 8; ++i) { const int k = (t_).k0 + 8 * i + (lane >> 3); v[i] = (f32x4){0.f, 0.f, 0.f, 0.f}; \
        if ((t_).srccol4 >= 0 && k < (t_).kvalid) v[i] = *(const f32x4*)((t_).W + (size_t)k * (t_).ldw + (t_).srccol4); } } while (0)
    TR_LOAD(cur);
    for (int it0 = gw; it0 < nit; it0 += NGW) {
#pragma unroll
        for (int i = 0; i < 8; ++i) { float* q = scr + (8 * i + (lane >> 3)) * 33 + 4 * (lane & 7); q[0] = v[i].x; q[1] = v[i].y; q[2] = v[i].z; q[3] = v[i].w; }
        const TrItem done = cur;
        if (it0 + NGW < nit) { cur = tr_item(a, tr_canon(set, it0 + NGW), lane); TR_LOAD(cur); }
        LDS_WAIT();
        const int c = lane & 7;
#pragma unroll
        for (int j = 0; j < 4; ++j) { const int n = (lane >> 3) + 8 * j; const float* sp = scr + (8 * c) * 33 + n;
            u32x4 o; o.x = pk2(sp[0 * 33], sp[1 * 33]); o.y = pk2(sp[2 * 33], sp[3 * 33]); o.z = pk2(sp[4 * 33], sp[5 * 33]); o.w = pk2(sp[6 * 33], sp[7 * 33]);
            *(u32x4*)(done.dst + (size_t)(done.drow0 + n) * done.Kdst + done.k0 + 8 * c) = o; }
        LDS_WAIT();
    }
#undef TR_LOAD
}

__device__ __forceinline__ void filter_phase(const Args& a, unsigned char* lds, int bid, int G) {
    const int tid = threadIdx.x, pos = tid >> 6, i = tid & 63;
    float* feats = (float*)lds; float* h1 = feats + 8 * 64; float* h2 = h1 + 8 * 64; float* tt = h2 + 8 * 64;
    const float* w1 = a.in[22]; const float* b1 = a.in[23]; const float* freq = a.in[24]; const float* w2 = a.in[25]; const float* b2 = a.in[26]; const float* w3 = a.in[27];
    const float MIND = -3.0701134573253944f, MAXD = -15.350567286626972f;
    for (int base = 0; base < 1280; base += 8 * G) {
        const int slot = base + pos * G + bid; const bool live = slot < 1280;
        const int item = (slot & 7) * 160 + (slot >> 3);
        const int lt = item < 256 ? 0 : 1, j = lt ? item - 256 : item, L = lt ? 1024 : 256;
        const float t = (float)j / (float)(L - 1), w = (6.283185307179586f / (float)L) * (float)j;
        __syncthreads();
        if (live && i < 33) { float v;
            if (i == 0) v = t;
            else { const int m = (i - 1) & 15; const float f = 1e-4f + (float)m * ((15.0f - 1e-4f) / 15.0f); v = i <= 16 ? cosf(f * w) : -sinf(f * w); }
            feats[pos * 64 + i] = v; if (i == 0) tt[pos] = t; }
        __syncthreads();
        if (live) { float sum = b1[i];
#pragma unroll 11
            for (int q = 0; q < 33; ++q) sum += feats[pos * 64 + q] * w1[q * 64 + i];
            h1[pos * 64 + i] = sinf(freq[i] * sum); }
        __syncthreads();
        if (live) { float sum = b2[i];
#pragma unroll 16
            for (int q = 0; q < 64; ++q) sum += h1[pos * 64 + q] * w2[q * 64 + i];
            h2[pos * 64 + i] = sinf(freq[i] * sum); }
        __syncthreads();
#pragma unroll 1
        for (int e = 0; e < 4; ++e) { const int col = tid + 512 * e;
            float wq[64];
#pragma unroll
            for (int q = 0; q < 64; ++q) wq[q] = w3[q * 2048 + col];
            const int dir = col >> 10, order = (col >> 9) & 1, c = col & 511;
            const float delta = fabsf(MIND + (float)(order * 512 + c) * ((MAXD - MIND) / 1023.0f));
#pragma unroll 1
            for (int pp = 0; pp < 8; ++pp) { const int sl2 = base + pp * G + bid; if (sl2 >= 1280) break; const int it2 = (sl2 & 7) * 160 + (sl2 >> 3);
                const int lt2 = it2 < 256 ? 0 : 1, j2 = lt2 ? it2 - 256 : it2, L2 = lt2 ? 1024 : 256;
                float sum = 0.f;
#pragma unroll
                for (int q = 0; q < 64; ++q) sum += h2[pp * 64 + q] * wq[q];
                float val = sum * expf(-tt[pp] * delta);
                int u = dir ? L2 + j2 : L2 - j2; if (dir && j2 == 0) { u = 0; val = 0.f; }
                bf16* RF = (bf16*)(a.ws + (lt2 ? WS_RF1 : WS_RF0));
                RF[((size_t)order * 512 + c) * (2 * L2) + u] = (bf16)f2bf(val); } }
    }
}

__device__ __forceinline__ void filter_h2_phase(const Args& a, float* H2G, unsigned char* lds, int bid, int G) {
    const int tid = threadIdx.x, pos = tid >> 6, i = tid & 63;
    float* feats = (float*)lds; float* h1 = feats + 8 * 64; float* w1s = h1 + 8 * 64; float* w2s = w1s + 33 * 64;
    const float* w1 = a.in[22]; const float* b1 = a.in[23]; const float* freq = a.in[24]; const float* w2 = a.in[25]; const float* b2 = a.in[26];
    __syncthreads();
    for (int e = tid; e < 33 * 64; e += NTHR) w1s[e] = w1[e];
    for (int e = tid; e < 64 * 64; e += NTHR) w2s[e] = w2[e];
    const float b1i = b1[i], b2i = b2[i], fri = freq[i];
    for (int base = 0; base < 1280; base += 8 * G) {
        const int item = base + pos * G + bid; const bool live = item < 1280;
        const int lt = item < 256 ? 0 : 1, j = lt ? item - 256 : item, L = lt ? 1024 : 256;
        const float t = (float)j / (float)(L - 1), w = (6.283185307179586f / (float)L) * (float)j;
        __syncthreads();
        if (live && i < 33) { float v;
            if (i == 0) v = t;
            else { const int m = (i - 1) & 15; const float f = 1e-4f + (float)m * ((15.0f - 1e-4f) / 15.0f); v = i <= 16 ? cosf(f * w) : -sinf(f * w); }
            feats[pos * 64 + i] = v; }
        __syncthreads();
        if (live) { float sum = b1i;
#pragma unroll 11
            for (int q = 0; q < 33; ++q) sum += feats[pos * 64 + q] * w1s[q * 64 + i];
            h1[pos * 64 + i] = sinf(fri * sum); }
        __syncthreads();
        if (live) { float sum = b2i;
#pragma unroll 16
            for (int q = 0; q < 64; ++q) sum += h1[pos * 64 + q] * w2s[q * 64 + i];
            H2G[(size_t)item * 64 + i] = sinf(fri * sum); }
    }
}
__device__ __forceinline__ void filter_out_phase(const Args& a, const float* H2G, unsigned char* lds, int bidx) {
    const int tid = threadIdx.x, lane = tid & 63, wave = __builtin_amdgcn_readfirstlane(tid >> 6);
    float* w3s = (float*)lds;
    const float* w3 = a.in[27];
    const float MIND = -3.0701134573253944f, MAXD = -15.350567286626972f;
    __syncthreads();
    for (int e = tid; e < 64 * 16; e += NTHR) w3s[e] = w3[(size_t)(e >> 4) * 2048 + 16 * bidx + (e & 15)];
    __syncthreads();
    for (int chunk = wave; chunk < 20; chunk += 8) {
        const int item = chunk * 64 + lane, lt = chunk < 4 ? 0 : 1, j = lt ? item - 256 : item, L = lt ? 1024 : 256;
        const float t = (float)j / (float)(L - 1);
        f32x4 h[16];
#pragma unroll
        for (int k = 0; k < 16; ++k) h[k] = *(const f32x4*)(H2G + (size_t)item * 64 + 4 * k);
        f32x4 acc[4];
#pragma unroll
        for (int c4 = 0; c4 < 4; ++c4) acc[c4] = (f32x4){0.f, 0.f, 0.f, 0.f};
#pragma unroll
        for (int k = 0; k < 16; ++k) {
#pragma unroll
            for (int e = 0; e < 4; ++e) { const int q = 4 * k + e; const float hv = h[k][e];
#pragma unroll
                for (int c4 = 0; c4 < 4; ++c4) acc[c4] += hv * *(const f32x4*)(w3s + q * 16 + 4 * c4); }
            asm volatile("" ::: "memory"); }
        bf16* RF = (bf16*)(a.ws + (lt ? WS_RF1 : WS_RF0));
#pragma unroll
        for (int c4 = 0; c4 < 4; ++c4)
#pragma unroll
            for (int e = 0; e < 4; ++e) { const int col = 16 * bidx + 4 * c4 + e, dir = col >> 10, order = (col >> 9) & 1, c = col & 511;
                const float delta = fabsf(MIND + (float)(order * 512 + c) * ((MAXD - MIND) / 1023.0f));
                float val = acc[c4][e] * __expf(-t * delta);
                int u = dir ? L + j : L - j; if (dir && j == 0) { u = 0; val = 0.f; }
                RF[((size_t)order * 512 + c) * (2 * L) + u] = (bf16)f2bf(val); }
    }
}

template <int MODE>
__device__ __forceinline__ void norm_rows(const float* X0, const float* X1, const float* normw, const float* MOD, int shoff, int scoff, bf16* __restrict__ H, float* OUT, int gw, int NGW, int lane) {
#pragma unroll 2
    for (int row = gw; row < NTOK; row += NGW) {
        const float* xp = row < NCTX ? X0 + (size_t)row * DM : X1 + (size_t)(row - NCTX) * DM;
        const f32x4* xr = (const f32x4*)xp + lane;
        f32x4 v[4]; float s = 0.f;
#pragma unroll
        for (int j = 0; j < 4; ++j) { v[j] = xr[64 * j]; s += (v[j].x * v[j].x + v[j].y * v[j].y) + (v[j].z * v[j].z + v[j].w * v[j].w); }
        const float rstd = 1.0f / sqrtf(wave_sum(s) * (1.0f / DM) + RMS_EPS);
        if (MODE == 1) {
#pragma unroll
            for (int j = 0; j < 4; ++j) { const f32x4 w = ((const f32x4*)normw)[lane + 64 * j]; ((f32x4*)(OUT + (size_t)row * DM))[lane + 64 * j] = v[j] * rstd * w; }
        } else {
            const int modrow = row < NCTX ? 8 : ((row - NCTX) >> 10);
            const float* mp = MOD + (size_t)modrow * MODW;
#pragma unroll
            for (int j = 0; j < 4; ++j) { const int q = lane + 64 * j;
                const f32x4 w = ((const f32x4*)normw)[q], scv = ((const f32x4*)(mp + scoff))[q], shv = ((const f32x4*)(mp + shoff))[q];
                const f32x4 h = v[j] * rstd * w * (1.0f + scv) + shv;
                u32x2 o; o.x = pk2(h.x, h.y); o.y = pk2(h.z, h.w);
                *(u32x2*)(H + (size_t)row * DM + 4 * q) = o; }
        }
    }
}

__device__ __forceinline__ void hyconv_phase(const bf16* P, const float* cw, const float* cb, bf16* VT, unsigned char* lds, int bid, int G) {
    constexpr int RS = 258, NIT = 192 * 6;
    const int tid = threadIdx.x;
    unsigned short* raw = (unsigned short*)lds;
    u32x4 pre[5];
#define HYC_LOAD(it_) do { const int tb_ = (it_) / 6, cq_ = (it_) - tb_ * 6, r0_ = tb_ * 64; \
        _Pragma("unroll") for (int k = 0; k < 5; ++k) { const int vid = tid + 512 * k; pre[k] = (u32x4){0u, 0u, 0u, 0u}; \
            if (vid < 66 * 32) { const int i = vid >> 5, v = vid & 31, row = r0_ - 1 + i; \
                if (row >= 0 && row < NTOK) pre[k] = *(const u32x4*)(P + (size_t)row * NPROJ + 1280 + cq_ * 256 + 8 * v); } } } while (0)
    const int first = bid, step = G, last = NIT;
    int item = first;
    if (item < last) HYC_LOAD(item);
    for (; item < last; item += step) {
        const int tb = item / 6, cq = item - tb * 6, r0 = tb * 64, SL = r0 < NCTX ? 256 : 64;
        __syncthreads();
#pragma unroll
        for (int k = 0; k < 5; ++k) { const int vid = tid + 512 * k;
            if (vid < 66 * 32) { const int i = vid >> 5, v = vid & 31; unsigned* q = (unsigned*)(raw + i * RS + 8 * v); q[0] = pre[k].x; q[1] = pre[k].y; q[2] = pre[k].z; q[3] = pre[k].w; } }
        if (item + step < last) HYC_LOAD(item + step);
        __syncthreads();
        const int t = tid & 63, cg = __builtin_amdgcn_readfirstlane(tid >> 6), pos = (r0 + t) & (SL - 1);
        const bool hasp = pos != 0, hasn = pos != SL - 1;
        const int chl = cq * 256 + cg * 32 + (t & 31);
        const float tw0 = cw[chl], tw1 = cw[1536 + chl], tw2 = cw[3072 + chl], tbb = cb[chl];
#pragma unroll
        for (int e = 0; e < 32; ++e) { const int cc = cg * 32 + e, ch = cq * 256 + cc;
            const float w0 = __builtin_bit_cast(float, __builtin_amdgcn_readlane(__builtin_bit_cast(int, tw0), e)), w1 = __builtin_bit_cast(float, __builtin_amdgcn_readlane(__builtin_bit_cast(int, tw1), e));
            const float w2 = __builtin_bit_cast(float, __builtin_amdgcn_readlane(__builtin_bit_cast(int, tw2), e)), bb = __builtin_bit_cast(float, __builtin_amdgcn_readlane(__builtin_bit_cast(int, tbb), e));
            float v = bb + w1 * bf2f(raw[(t + 1) * RS + cc]);
            if (hasp) v += w0 * bf2f(raw[t * RS + cc]);
            if (hasn) v += w2 * bf2f(raw[(t + 2) * RS + cc]);
            VT[(size_t)ch * NTOK + r0 + t] = (bf16)f2bf(v); }
    }
#undef HYC_LOAD
}

__device__ __forceinline__ void xbc_conv_phase(const bf16* __restrict__ P, const float* __restrict__ cw, const float* __restrict__ cb, bf16* __restrict__ XC, int bid, int G) {
    const int tid = threadIdx.x; if (tid >= 480) return;
    const int v = tid % 96, rr = tid / 96;
    float w0[8], w1[8], w2[8], bb[8];
#pragma unroll
    for (int e = 0; e < 8; ++e) { const int ch = 8 * v + e; w0[e] = cw[ch]; w1[e] = cw[768 + ch]; w2[e] = cw[1536 + ch]; bb[e] = cb[ch]; }
    for (int it = bid; it * 5 < NTOK; it += G) { const int row = it * 5 + rr; if (row >= NTOK) break;
        const int SL = row < NCTX ? 256 : 64, pos = row & (SL - 1);
        const bf16* pp = P + (size_t)row * NPROJ + 512 + 8 * v;
        const u32x4 c = *(const u32x4*)pp; u32x4 pv = (u32x4){0u, 0u, 0u, 0u}, nx = (u32x4){0u, 0u, 0u, 0u};
        if (pos != 0) pv = *(const u32x4*)(pp - NPROJ);
        if (pos != SL - 1) nx = *(const u32x4*)(pp + NPROJ);
        float o[8];
        const unsigned cc[4] = {c.x, c.y, c.z, c.w}, pc[4] = {pv.x, pv.y, pv.z, pv.w}, nc[4] = {nx.x, nx.y, nx.z, nx.w};
#pragma unroll
        for (int e = 0; e < 8; ++e) { const int q = e >> 1; const bool hi = e & 1;
            const float xc = hi ? bf2f(cc[q] >> 16) : bf2f(cc[q] & 0xffffu), xp = hi ? bf2f(pc[q] >> 16) : bf2f(pc[q] & 0xffffu), xn = hi ? bf2f(nc[q] >> 16) : bf2f(nc[q] & 0xffffu);
            o[e] = silu_f(bb[e] + w1[e] * xc + w0[e] * xp + w2[e] * xn); }
        u32x4 w; w.x = pk2(o[0], o[1]); w.y = pk2(o[2], o[3]); w.z = pk2(o[4], o[5]); w.w = pk2(o[6], o[7]);
        *(u32x4*)(XC + (size_t)row * 768 + 8 * v) = w; }
}

constexpr int SST = 72;
__device__ __forceinline__ bf16x8 pack8(const float* o) { u32x4 w; w.x = pk2(o[0], o[1]); w.y = pk2(o[2], o[3]); w.z = pk2(o[4], o[5]); w.w = pk2(o[6], o[7]); return __builtin_bit_cast(bf16x8, w); }
__device__ __forceinline__ void ssd_chunk_phase(const Args& a, const bf16* XC, const float* DT, float* YF, float* YB, unsigned char* lds, int bid, int G) {
    const int tid = threadIdx.x, lane = tid & 63, wave = __builtin_amdgcn_readfirstlane(tid >> 6), l15 = lane & 15, g4 = lane >> 4;
    bf16* BS = (bf16*)lds;
    bf16* CS = BS + 64 * SST;
    bf16* BST = CS + 64 * SST;
    bf16* XT = BST + 64 * SST;
    bf16* XDT = XT + 64 * SST;
    bf16* XX = XDT + 64 * SST;
    bf16* S16 = XX + 64 * SST;
    float* Wv = (float*)(S16 + 64 * SST); float* DTV = Wv + 64; float* DEC = DTV + 64; float* EW = DEC + 64; float* TOT = EW + 64;
    const int nun = G == 256 ? (bid < 128 ? 1 : 2) : (384 - bid + G - 1) / G;
    const int sx = tid & 63, c8 = tid >> 6;
    for (int ui = 0; ui < nun; ++ui) {
        const int unit = G == 256 ? (bid < 128 ? bid : 128 + (bid - 128) * 2 + ui) : bid + ui * G;
        int seq, h, dir;
        if (unit < 128) { seq = 16 + (unit >> 4); h = (unit >> 1) & 7; dir = unit & 1; } else { const int u = unit - 128; seq = u >> 4; h = (u >> 1) & 7; dir = u & 1; }
        const bool lat = seq >= 16; const int L = lat ? 1024 : 256, row0 = lat ? NCTX + (seq - 16) * 1024 : seq * 256, g = h >> 2;
        const float A = -expf(a.in[17][dir * 8 + h]), dtb = a.in[16][dir * 8 + h], Dh = a.in[18][h];
        float* Yd = dir ? YB : YF;
        const int ni = wave >> 1, ph = wave & 1, ti = wave >> 1;
        f32x4 st[2];
#pragma unroll
        for (int jj = 0; jj < 2; ++jj) { const int p = 16 * (2 * ph + jj) + l15, n0 = 16 * ni + 4 * g4;
            if (lat) st[jj] = *(const f32x4*)(a.in[2] + ((size_t)(((seq - 16) * 2 + dir) * 8 + h)) * 4096 + p * 64 + n0); else st[jj] = (f32x4){0.f, 0.f, 0.f, 0.f}; }
        const int nch = L / 64;
        u32x4 pxv, pbv, pcv; float predt;
#define SSD_PREFETCH(ci_) do { const int t0p = dir ? L - ((ci_) + 1) * 64 : (ci_) * 64; const bf16* xp_ = XC + (size_t)(row0 + t0p + sx) * 768 + 8 * c8; \
            pxv = *(const u32x4*)(xp_ + h * 64); pbv = *(const u32x4*)(xp_ + 512 + g * 64); pcv = *(const u32x4*)(xp_ + 640 + g * 64); \
            predt = DT[(size_t)(row0 + t0p + lane) * 16 + dir * 8 + h]; } while (0)
        SSD_PREFETCH(0);
        for (int ci = 0; ci < nch; ++ci) {
            const int t0 = dir ? L - (ci + 1) * 64 : ci * 64;
            __syncthreads();
            if (wave == 0) {
                const float x = predt + dtb; const float dt = x > 20.f ? x : log1pf(expf(x)); float v = dt * A;
                if (dir) v = __shfl(v, 63 - lane);
#pragma unroll
                for (int off = 1; off < 64; off <<= 1) { const float u = __shfl_up(v, off); if (lane >= off) v += u; }
                const float tot = __shfl(v, 63);
                if (dir) v = __shfl(v, 63 - lane);
                DTV[lane] = dt; Wv[lane] = v; DEC[lane] = expf(tot - v); EW[lane] = expf(v); if (lane == 0) TOT[0] = expf(tot);
            }
#pragma unroll
            for (int jj = 0; jj < 2; ++jj) { const int p = 16 * (2 * ph + jj) + l15, n0 = 16 * ni + 4 * g4;
                u32x2 w; w.x = pk2(st[jj].x, st[jj].y); w.y = pk2(st[jj].z, st[jj].w); *(u32x2*)(S16 + p * SST + n0) = w; }
            *(u32x4*)(BS + sx * SST + 8 * c8) = pbv; *(u32x4*)(CS + sx * SST + 8 * c8) = pcv;
            { const unsigned bw[4] = {pbv.x, pbv.y, pbv.z, pbv.w};
#pragma unroll
              for (int e = 0; e < 8; ++e) BST[(8 * c8 + e) * SST + sx] = (bf16)((e & 1) ? (bw[e >> 1] >> 16) : (bw[e >> 1] & 0xffffu)); }
            const u32x4 xv = pxv;
            if (ci + 1 < nch) SSD_PREFETCH(ci + 1);
            __syncthreads();
            { const float dts = DTV[sx], dcs = DEC[sx]; const unsigned xw[4] = {xv.x, xv.y, xv.z, xv.w};
#pragma unroll
              for (int e = 0; e < 8; ++e) { const unsigned hb = (e & 1) ? (xw[e >> 1] >> 16) : (xw[e >> 1] & 0xffffu); const float xf = bf2f(hb), xd = xf * dts;
                  XX[(8 * c8 + e) * SST + sx] = (bf16)hb; XT[(8 * c8 + e) * SST + sx] = (bf16)f2bf(xd); XDT[(8 * c8 + e) * SST + sx] = (bf16)f2bf(xd * dcs); } }
            __syncthreads();
            const int tl = 16 * ti + l15;
            bf16x8 cfr[2];
#pragma unroll
            for (int kb = 0; kb < 2; ++kb) cfr[kb] = *(const bf16x8*)(CS + tl * SST + 32 * kb + 8 * g4);
            f32x4 gt[4];
#pragma unroll
            for (int si = 0; si < 4; ++si) { gt[si] = (f32x4){0.f, 0.f, 0.f, 0.f};
#pragma unroll
                for (int kb = 0; kb < 2; ++kb) { const bf16x8 af = *(const bf16x8*)(BS + (16 * si + l15) * SST + 32 * kb + 8 * g4); gt[si] = __builtin_amdgcn_mfma_f32_16x16x32_bf16(af, cfr[kb], gt[si], 0, 0, 0); } }
            const float wt = Wv[tl], ewt = EW[tl];
            bf16x8 mfr[2], csc[2];
#pragma unroll
            for (int kb = 0; kb < 2; ++kb) { float m[8];
#pragma unroll
                for (int hh = 0; hh < 2; ++hh) { const int si = 2 * kb + hh; const f32x4 ws = *(const f32x4*)(Wv + 16 * si + 4 * g4);
#pragma unroll
                    for (int r = 0; r < 4; ++r) { const int sidx = 16 * si + 4 * g4 + r; const bool ok = dir ? (sidx >= tl) : (sidx <= tl);
                        m[4 * hh + r] = ok ? gt[si][r] * __expf(fminf(wt - ws[r], 0.f)) : 0.f; } }
                mfr[kb] = pack8(m);
                float cs[8];
#pragma unroll
                for (int j = 0; j < 8; ++j) cs[j] = bf2f((unsigned)(unsigned short)cfr[kb][j]) * ewt;
                csc[kb] = pack8(cs); }
#pragma unroll
            for (int jj = 0; jj < 2; ++jj) { const int pl = 16 * (2 * ph + jj) + l15;
                f32x4 acc = (f32x4){0.f, 0.f, 0.f, 0.f};
#pragma unroll
                for (int kb = 0; kb < 2; ++kb) { const u32x2 lo = *(const u32x2*)(XT + pl * SST + 32 * kb + 4 * g4), hi = *(const u32x2*)(XT + pl * SST + 32 * kb + 16 + 4 * g4);
                    const u32x4 bxw = (u32x4){lo.x, lo.y, hi.x, hi.y};
                    acc = __builtin_amdgcn_mfma_f32_16x16x32_bf16(mfr[kb], __builtin_bit_cast(bf16x8, bxw), acc, 0, 0, 0); }
#pragma unroll
                for (int kb = 0; kb < 2; ++kb) { const bf16x8 bs = *(const bf16x8*)(S16 + pl * SST + 32 * kb + 8 * g4);
                    acc = __builtin_amdgcn_mfma_f32_16x16x32_bf16(csc[kb], bs, acc, 0, 0, 0); }
                if (dir == 0) { const u32x2 xx = *(const u32x2*)(XX + pl * SST + 16 * ti + 4 * g4);
                    acc.x += Dh * bf2f(xx.x & 0xffffu); acc.y += Dh * bf2f(xx.x >> 16); acc.z += Dh * bf2f(xx.y & 0xffffu); acc.w += Dh * bf2f(xx.y >> 16); }
                float* yp = Yd + (size_t)(row0 + t0 + 16 * ti + 4 * g4) * 512 + h * 64 + pl;
                yp[0] = acc.x; yp[512] = acc.y; yp[1024] = acc.z; yp[1536] = acc.w; }
            const float dtot = TOT[0];
#pragma unroll
            for (int jj = 0; jj < 2; ++jj) { st[jj] = st[jj] * dtot;
#pragma unroll
                for (int kb = 0; kb < 2; ++kb) { const bf16x8 af = *(const bf16x8*)(BST + (16 * ni + l15) * SST + 32 * kb + 8 * g4), bfv = *(const bf16x8*)(XDT + (16 * (2 * ph + jj) + l15) * SST + 32 * kb + 8 * g4);
                    st[jj] = __builtin_amdgcn_mfma_f32_16x16x32_bf16(af, bfv, st[jj], 0, 0, 0); } }
        }
#undef SSD_PREFETCH
        if (!lat) {
#pragma unroll
            for (int jj = 0; jj < 2; ++jj) { const int p = 16 * (2 * ph + jj) + l15, n0 = 16 * ni + 4 * g4;
                *(f32x4*)(a.out + (size_t)NTOK * DM + ((size_t)((seq * 2 + dir) * 8 + h)) * 4096 + p * 64 + n0) = st[jj]; } }
    }
}

__device__ __forceinline__ void ssd_post_rows(const float* __restrict__ YF, const float* __restrict__ YB, const bf16* __restrict__ P, const float* __restrict__ nw, bf16* __restrict__ Y, int gw, int NGW, int lane) {
#pragma unroll 2
    for (int row = gw; row < NTOK; row += NGW) {
        const int c0 = lane * 8;
        const f32x4 f0 = *(const f32x4*)(YF + (size_t)row * 512 + c0), f1 = *(const f32x4*)(YF + (size_t)row * 512 + c0 + 4);
        const f32x4 g0 = *(const f32x4*)(YB + (size_t)row * 512 + c0), g1 = *(const f32x4*)(YB + (size_t)row * 512 + c0 + 4);
        const u32x4 zz = *(const u32x4*)(P + (size_t)row * NPROJ + c0);
        float y[8], z[8];
        z[0] = bf2f(zz.x & 0xffffu); z[1] = bf2f(zz.x >> 16); z[2] = bf2f(zz.y & 0xffffu); z[3] = bf2f(zz.y >> 16);
        z[4] = bf2f(zz.z & 0xffffu); z[5] = bf2f(zz.z >> 16); z[6] = bf2f(zz.w & 0xffffu); z[7] = bf2f(zz.w >> 16);
        y[0] = f0.x + g0.x; y[1] = f0.y + g0.y; y[2] = f0.z + g0.z; y[3] = f0.w + g0.w; y[4] = f1.x + g1.x; y[5] = f1.y + g1.y; y[6] = f1.z + g1.z; y[7] = f1.w + g1.w;
        float s = 0.f;
#pragma unroll
        for (int e = 0; e < 8; ++e) { y[e] *= silu_f(z[e]); s += y[e] * y[e]; }
        const float rstd = 1.0f / sqrtf(wave_sum(s) * (1.0f / 512.0f) + RMS_EPS);
        const f32x4 w0 = *(const f32x4*)(nw + c0), w1 = *(const f32x4*)(nw + c0 + 4);
        u32x4 o; o.x = pk2(y[0] * rstd * w0.x, y[1] * rstd * w0.y); o.y = pk2(y[2] * rstd * w0.z, y[3] * rstd * w0.w);
        o.z = pk2(y[4] * rstd * w1.x, y[5] * rstd * w1.y); o.w = pk2(y[6] * rstd * w1.z, y[7] * rstd * w1.w);
        *(u32x4*)(Y + (size_t)row * DM + c0) = o;
    }
}

template <int L, int UPI>
__device__ __forceinline__ void hyena_item(int item, const bf16* VT, const bf16* RF, const float* skip, bf16* Y, unsigned char* lds) {
    constexpr int NP = L / 32, WPU = 8 / UPI, PPW = NP / WPU, ZS = L + 56, RL = 2 * L + 32;
    bf16* Z = (bf16*)lds;
    bf16* R = Z + UPI * 8 * ZS;
    const int tid = threadIdx.x, wave = __builtin_amdgcn_readfirstlane(tid >> 6), lane = tid & 63, ul = wave / WPU, wq = wave % WPU;
    __syncthreads();
    {
        constexpr int NZ = UPI * 8 * (ZS / 8), NZT = (NZ + NTHR - 1) / NTHR, NR_ = UPI * 2 * (RL / 8), NRT = (NR_ + NTHR - 1) / NTHR;
        u32x4 zv[NZT], rv[NRT];
#pragma unroll
        for (int k = 0; k < NZT; ++k) { const int e = tid + NTHR * k; zv[k] = (u32x4){0u, 0u, 0u, 0u};
            if (e < NZ) { const int u = e / (8 * (ZS / 8)), rem = e - u * (8 * (ZS / 8)), b = rem / (ZS / 8), q = rem - b * (ZS / 8);
                const int unit = item * UPI + u, c = L == 1024 ? unit : unit >> 1, rowbase = L == 1024 ? NCTX : (unit & 1) * 2048; const int sidx = 8 * q - 16;
                if (sidx >= 0 && sidx < L) zv[k] = *(const u32x4*)(VT + (size_t)c * NTOK + rowbase + b * L + sidx); } }
#pragma unroll
        for (int k = 0; k < NRT; ++k) { const int e = tid + NTHR * k; rv[k] = (u32x4){0u, 0u, 0u, 0u};
            if (e < NR_) { const int uo = e / (RL / 8), q = e - uo * (RL / 8), u = uo >> 1, o = uo & 1;
                const int unit = item * UPI + u, c = L == 1024 ? unit : unit >> 1;
                if (8 * q < 2 * L) rv[k] = *(const u32x4*)(RF + ((size_t)o * 512 + c) * (2 * L) + 8 * q); } }
#pragma unroll
        for (int k = 0; k < NZT; ++k) { const int e = tid + NTHR * k;
            if (e < NZ) { const int u = e / (8 * (ZS / 8)), rem = e - u * (8 * (ZS / 8)), b = rem / (ZS / 8), q = rem - b * (ZS / 8); *(u32x4*)(Z + (u * 8 + b) * ZS + 8 * q) = zv[k]; } }
#pragma unroll
        for (int k = 0; k < NRT; ++k) { const int e = tid + NTHR * k;
            if (e < NR_) { const int uo = e / (RL / 8), q = e - uo * (RL / 8); *(u32x4*)(R + uo * RL + 8 * q) = rv[k]; } }
    }
    __syncthreads();
    const int unit = item * UPI + ul, c = L == 1024 ? unit : unit >> 1, rowbase = L == 1024 ? NCTX : (unit & 1) * 2048;
    const int i = lane & 15, g = lane >> 4, tau = i >> 3, b = i & 7;
    const bf16* Zp = Z + ul * 8 * ZS;
    f32x4 acc[PPW], zz1[PPW];
#pragma unroll
    for (int o = 0; o < 2; ++o) {
#pragma unroll
        for (int pp = 0; pp < PPW; ++pp) acc[pp] = (f32x4){0.f, 0.f, 0.f, 0.f};
        const bf16* Rp = R + (ul * 2 + o) * RL + L - 16 + 8 * g - i;
        const int p0 = wq * PPW;
        const bf16* Zb = Zp + b * ZS + 16 * tau + 8 * g;
#define HY_AFRAG(dl_) ((const bf16x8_u*)(Rp + 32 * (dl_)))->v
#pragma unroll 1
        for (int dl = -(p0 + PPW - 1); dl < -p0; ++dl) { const bf16x8 Af = HY_AFRAG(dl);
#pragma unroll
            for (int pp = 0; pp < PPW; ++pp) { const int m = p0 + pp + dl;
                if (m >= 0) { const bf16x8 Bf = *(const bf16x8*)(Zb + 32 * m); acc[pp] = __builtin_amdgcn_mfma_f32_16x16x32_bf16(Af, Bf, acc[pp], 0, 0, 0); } } }
        {
            const int dl0 = -p0, dl1 = NP - p0 - PPW + 1;
            bf16x8 Bf[PPW];
#pragma unroll
            for (int pp = 0; pp < PPW - 1; ++pp) Bf[pp] = *(const bf16x8*)(Zb + 32 * pp);
#pragma unroll 1
            for (int dl = dl0; dl <= dl1; dl += PPW) {
#pragma unroll
                for (int k = 0; k < PPW; ++k) {
                    if (dl + k <= dl1) {
                        Bf[(k + PPW - 1) % PPW] = *(const bf16x8*)(Zb + 32 * (p0 + dl + k + PPW - 1));
                        const bf16x8 Af = HY_AFRAG(dl + k);
#pragma unroll
                        for (int pp = 0; pp < PPW; ++pp) acc[pp] = __builtin_amdgcn_mfma_f32_16x16x32_bf16(Af, Bf[(pp + k) % PPW], acc[pp], 0, 0, 0);
                    }
                }
            }
        }
#pragma unroll 1
        for (int dl = NP - p0 - PPW + 2; dl <= NP - p0; ++dl) { const bf16x8 Af = HY_AFRAG(dl);
#pragma unroll
            for (int pp = 0; pp < PPW; ++pp) { const int m = p0 + pp + dl;
                if (m <= NP) { const bf16x8 Bf = *(const bf16x8*)(Zb + 32 * m); acc[pp] = __builtin_amdgcn_mfma_f32_16x16x32_bf16(Af, Bf, acc[pp], 0, 0, 0); } } }
#undef HY_AFRAG
        const float sk = skip[o * 512 + c];
        u32x2 gtv[PPW];
#pragma unroll
        for (int pp = 0; pp < PPW; ++pp) { const int t = 32 * (wq * PPW + pp) + 16 * tau + 4 * g; gtv[pp] = *(const u32x2*)(VT + (size_t)((o + 1) * 512 + c) * NTOK + rowbase + b * L + t); }
#pragma unroll
        for (int pp = 0; pp < PPW; ++pp) { const int t = 32 * (wq * PPW + pp) + 16 * tau + 4 * g;
            const u32x2 gt = gtv[pp];
            f32x4 prev;
            if (o == 0) { const u32x2 pz = *(const u32x2*)(Zp + b * ZS + 16 + t); prev = (f32x4){bf2f(pz.x & 0xffffu), bf2f(pz.x >> 16), bf2f(pz.y & 0xffffu), bf2f(pz.y >> 16)}; }
            else prev = zz1[pp];
            const f32x4 gate = (f32x4){bf2f(gt.x & 0xffffu), bf2f(gt.x >> 16), bf2f(gt.y & 0xffffu), bf2f(gt.y >> 16)};
            const f32x4 val = gate * (acc[pp] + prev * sk);
            if (o == 0) zz1[pp] = val;
            else if (L == 1024 && UPI == 2) zz1[pp] = val;
            else { bf16* yp = Y + (size_t)(rowbase + b * L + t) * DM + 512 + c;
                yp[0] = (bf16)f2bf(val.x); yp[DM] = (bf16)f2bf(val.y); yp[2 * DM] = (bf16)f2bf(val.z); yp[3 * DM] = (bf16)f2bf(val.w); } }
        if (o == 1 && L == 1024 && UPI == 2) {
            u32x2* EX = (u32x2*)(lds + 65536);
            if (ul == 1) {
#pragma unroll
                for (int pp = 0; pp < PPW; ++pp) { u32x2 w; w.x = pk2(zz1[pp].x, zz1[pp].y); w.y = pk2(zz1[pp].z, zz1[pp].w); EX[(wq * PPW + pp) * 64 + lane] = w; } }
            __syncthreads();
            if (ul == 0) {
#pragma unroll
                for (int pp = 0; pp < PPW; ++pp) { const int t = 32 * (wq * PPW + pp) + 16 * tau + 4 * g; const u32x2 pw = EX[(wq * PPW + pp) * 64 + lane];
                    unsigned* yp = (unsigned*)(Y + (size_t)(rowbase + b * L + t) * DM + 512 + c);
                    yp[0] = f2bf(zz1[pp].x) | (pw.x << 16); yp[DM / 2] = f2bf(zz1[pp].y) | (pw.x & 0xffff0000u); yp[DM] = f2bf(zz1[pp].z) | (pw.y << 16); yp[3 * DM / 2] = f2bf(zz1[pp].w) | (pw.y & 0xffff0000u); } }
        }
        if (o == 0) {
            __syncthreads();
#pragma unroll
            for (int pp = 0; pp < PPW; ++pp) { const int t = 32 * (wq * PPW + pp) + 16 * tau + 4 * g;
                u32x2 w; w.x = pk2(zz1[pp].x, zz1[pp].y); w.y = pk2(zz1[pp].z, zz1[pp].w);
                *(u32x2*)(Z + (ul * 8 + b) * ZS + 16 + t) = w; }
            __syncthreads();
        }
    }
}

#define XB_TMO      128
#define XB_XCNT(j)  (256  + 64 * (j))
#define XB_XSUB(j)  (1280 + 64 * (j))
#define XB_XGEN(j)  (2304 + 64 * (j))
#define XB_TOP      3328
#define XB_TOPGEN   3392
#define XCD_BAR_WORDS 3456
#define XB_SPIN_CAP (1u << 18)

__device__ __forceinline__ unsigned xb_ld(unsigned* p)              { return __hip_atomic_load(p, __ATOMIC_RELAXED, __HIP_MEMORY_SCOPE_AGENT); }
__device__ __forceinline__ unsigned xb_add(unsigned* p, unsigned v) { return __hip_atomic_fetch_add(p, v, __ATOMIC_RELAXED, __HIP_MEMORY_SCOPE_AGENT); }
__device__ __forceinline__ unsigned xb_xcc_id() { return (unsigned)__builtin_amdgcn_s_getreg((3 << 11) | 20) & 0xFu; }
#define XB_SPIN(cond, bar) do { unsigned _sp = 0; while (cond) { __builtin_amdgcn_s_sleep(1); \
    if ((++_sp & 255u) == 0u) { if (xb_ld(&(bar)[XB_TMO])) break; if (_sp > XB_SPIN_CAP) { atomicAdd(&(bar)[XB_TMO], 1u); break; } } } } while (0)

struct XcdBarrier {
    unsigned* bar; unsigned x;
    volatile LAS unsigned* st;
};

__device__ __forceinline__ XcdBarrier xcd_barrier_post(unsigned* bar, volatile LAS unsigned* st) {
    XcdBarrier b; b.bar = bar; b.x = xb_xcc_id(); b.st = st;
    if (threadIdx.x == 0) (void)xb_add(&bar[XB_XCNT(b.x)], 1u);
    return b;
}
__device__ __forceinline__ void xcd_barrier_complete(unsigned* bar, unsigned x, unsigned& nloc, unsigned& nx) {
    const unsigned G = gridDim.x * gridDim.y * gridDim.z;
    unsigned sum, cnt, mine, sp = 0u;
    for (;;) {
        sum = 0u; cnt = 0u; mine = 0u;
#pragma unroll
        for (unsigned j = 0; j < 16; ++j) { const unsigned c = xb_ld(&bar[XB_XCNT(j)]); sum += c; cnt += (c > 0u) ? 1u : 0u; mine = (j == x) ? c : mine; }
        if (sum == G) break;
        __builtin_amdgcn_s_sleep(1);
        if ((++sp & 255u) == 0u) { if (xb_ld(&bar[XB_TMO])) break; if (sp > XB_SPIN_CAP) { atomicAdd(&bar[XB_TMO], 1u); break; } }
    }
    nloc = mine > 0u ? mine : 1u; nx = cnt > 0u ? cnt : 1u;
}

__device__ __forceinline__ void xcd_barrier(const XcdBarrier& b) {
    asm volatile("s_waitcnt vmcnt(0)" ::: "memory");
    __syncthreads();
    if (threadIdx.x == 0) {
        unsigned* bar = b.bar;
        __builtin_amdgcn_s_waitcnt(0);
        unsigned nloc = b.st[0], nx = b.st[1];
        if (nloc == 0u) { xcd_barrier_complete(bar, b.x, nloc, nx); b.st[0] = nloc; b.st[1] = nx; }
        const unsigned old = xb_add(&bar[XB_XSUB(b.x)], 1u);
        const unsigned gen = old / nloc;
        if (old + 1u == (gen + 1u) * nloc) {
            __builtin_amdgcn_fence(__ATOMIC_RELEASE, "agent");
            asm volatile("s_waitcnt vmcnt(0)" ::: "memory");
            const unsigned og = xb_add(&bar[XB_TOP], 1u);
            const unsigned tg = og / nx;
            if (og + 1u == (tg + 1u) * nx) xb_add(&bar[XB_TOPGEN], 1u);
            else XB_SPIN(xb_ld(&bar[XB_TOPGEN]) == tg, bar);
            __builtin_amdgcn_fence(__ATOMIC_ACQUIRE, "agent");
            xb_add(&bar[XB_XGEN(b.x)], 1u);
            asm volatile("s_waitcnt vmcnt(0)" ::: "memory");
        } else {
            XB_SPIN(xb_ld(&bar[XB_XGEN(b.x)]) == gen, bar);
            __builtin_amdgcn_fence(__ATOMIC_ACQUIRE, "agent");
            asm volatile("s_waitcnt vmcnt(0)" ::: "memory");
        }
    }
    __syncthreads();
}

#define CG_SYNC() do { asm volatile("s_waitcnt vmcnt(0)" ::: "memory"); grid.sync(); } while (0)
#define GRID_SYNC() xcd_barrier(xbar)
#ifndef REP_P0
#define REP_P0 1
#endif
#ifndef REP_P6A
#define REP_P6A 1
#endif
#ifndef REP_P6B
#define REP_P6B 1
#endif
#ifndef REP_P7
#define REP_P7 1
#endif
__global__ void __launch_bounds__(NTHR, 2) fwd_megakernel(Args a) {
    extern __shared__ __attribute__((aligned(16))) unsigned char lds[];
    cg::grid_group grid = cg::this_grid();
    const int tid = threadIdx.x, lane = tid & 63, wave = __builtin_amdgcn_readfirstlane(tid >> 6);
    const int bid = blockIdx.x, G = gridDim.x, gw = bid * NWAVES + wave, NGW = G * NWAVES;
    unsigned char* ws = a.ws;
    float* MOD = (float*)(ws + WS_MOD); float* DT = (float*)(ws + WS_DT);
    bf16* H = (bf16*)(ws + WS_H); bf16* U = (bf16*)(ws + WS_U); bf16* P = U; bf16* Y = H;
    float* X2 = (float*)(ws + WS_X2); float* YF = X2; float* YB = X2 + (size_t)NTOK * 512;
    bf16* VT = (bf16*)(ws + WS_VT);
    float* X1 = a.out;
    PG8_LAS unsigned char* ldsl = (PG8_LAS unsigned char*)lds;
    volatile LAS unsigned* xst = (volatile LAS unsigned*)((LAS unsigned char*)lds + 131072 + 64);
    if (tid < 2) xst[tid] = 0u;
    __syncthreads();
    const XcdBarrier xbar = xcd_barrier_post((unsigned*)ws, xst);

    const bool defer = (G == 256);
    ada_phase(a.in[3], a.in[4], a.in[5], a.in[6], MOD, lds, bid, G);
    __syncthreads();
    transpose_phase(a, lds, (G - 1 - bid) * NWAVES + wave, NGW, wave, lane, defer ? 0 : 2);
    __syncthreads();
    if (!defer) { filter_phase(a, lds, bid, G); __syncthreads(); }
    if (G > (1 << 30)) grid.sync();
    GRID_SYNC();
    norm_rows<0>(a.in[0], a.in[1], a.in[7], MOD, 0 * DM, 1 * DM, H, nullptr, gw, NGW, lane);
    GRID_SYNC();
    { pg8::Gemm g{H, (const bf16*)(ws + WS_WB1), NTOK, 2 * FFP, DM}; pg8::StaticOrder S; S.init(NTOK, 2 * FFP, G, bid);
      pg8::EpiSwiGLU E{U, FFP}; pg8::gemm_phase<pg8::EpiSwiGLU, pg8::StaticOrder, true, true>(ldsl, g, S, E); }
    if (defer && bid >= 32) transpose_phase(a, lds, (bid - 32) * NWAVES + wave, 224 * NWAVES, wave, lane, 3);
    GRID_SYNC();
    { pg8::Gemm g{U, (const bf16*)(ws + WS_WD1), NTOK, DM, FFP}; pg8::StaticOrder S; S.init(NTOK, DM, G, bid);
      pg8::EpiResid E{a.in[0], a.in[1], X1, MOD + 2 * DM, 0.5f}; pg8::gemm_phase<pg8::EpiResid, pg8::StaticOrder, true, true>(ldsl, g, S, E); }
    if (defer && bid >= 192) { transpose_phase(a, lds, (bid - 192) * NWAVES + wave, 64 * NWAVES, wave, lane, 1); filter_h2_phase(a, (float*)(ws + WS_H2G), lds, bid - 192, 64); }
    GRID_SYNC();
    norm_rows<0>(X1, X1 + (size_t)NCTX * DM, a.in[11], MOD, 3 * DM, 4 * DM, H, nullptr, gw, NGW, lane);
    GRID_SYNC();
    { pg8::Gemm g{H, (const bf16*)(ws + WS_WIN), NTOK, NPROJ, DM}; pg8::StaticOrder S; S.init(NTOK, NPROJ, G, bid);
      pg8::EpiProj E{P, DT}; pg8::gemm_phase<pg8::EpiProj, pg8::StaticOrder, true, true>(ldsl, g, S, E); }
    if (defer && bid >= 64) { if (bid < 192) filter_out_phase(a, (const float*)(ws + WS_H2G), lds, bid - 64); __syncthreads(); transpose_phase(a, lds, (bid - 64) * NWAVES + wave, 192 * NWAVES, wave, lane, 4); }
    GRID_SYNC();
    hyconv_phase(P, a.in[20], a.in[21], VT, lds, bid, G);
    xbc_conv_phase(P, a.in[14], a.in[15], (bf16*)(ws + WS_XC), bid, G);
    GRID_SYNC();
    ssd_chunk_phase(a, (const bf16*)(ws + WS_XC), DT, YF, YB, lds, bid, G);
    for (int item = bid; item < 256 + 256; item += G) {
        const int it = item & 255, cp = (G == 256) ? ((it & 7) * 32 + (it >> 3)) : it;
        if (item < 256) hyena_item<1024, 2>(cp, VT, (const bf16*)(ws + WS_RF1), a.in[28], Y, lds);
    }
    if (G == 256) { if (bid >= 128) { const int cq = (bid & 7) * 16 + ((bid - 128) >> 3); hyena_item<256, 8>(cq, VT, (const bf16*)(ws + WS_RF0), a.in[28], Y, lds); } }
    else for (int item = bid; item < 128; item += G) hyena_item<256, 8>(item, VT, (const bf16*)(ws + WS_RF0), a.in[28], Y, lds);
    GRID_SYNC();
    ssd_post_rows(YF, YB, P, a.in[19], Y, gw, NGW, lane);
    GRID_SYNC();
    { pg8::Gemm g{Y, (const bf16*)(ws + WS_WOUT), NTOK, DM, DM}; pg8::StaticOrder S; S.init(NTOK, DM, G, bid);
      pg8::EpiResid E{X1, X1 + (size_t)NCTX * DM, X2, MOD + 5 * DM, 1.0f}; pg8::gemm_phase<pg8::EpiResid, pg8::StaticOrder, true, true>(ldsl, g, S, E); }
    if (defer && bid >= 192) transpose_phase(a, lds, (bid - 192) * NWAVES + wave, 64 * NWAVES, wave, lane, 5);
    GRID_SYNC();
    norm_rows<0>(X2, X2 + (size_t)NCTX * DM, a.in[29], MOD, 6 * DM, 7 * DM, H, nullptr, gw, NGW, lane);
    GRID_SYNC();
    { pg8::Gemm g{H, (const bf16*)(ws + WS_WB2), NTOK, 2 * FFP, DM}; pg8::StaticOrder S; S.init(NTOK, 2 * FFP, G, bid);
      pg8::EpiSwiGLU E{U, FFP}; pg8::gemm_phase<pg8::EpiSwiGLU, pg8::StaticOrder, true, true>(ldsl, g, S, E); }
    GRID_SYNC();
    { pg8::Gemm g{U, (const bf16*)(ws + WS_WD2), NTOK, DM, FFP}; pg8::StaticOrder S; S.init(NTOK, DM, G, bid);
      pg8::EpiResid E{X2, X2 + (size_t)NCTX * DM, a.out, MOD + 8 * DM, 0.5f}; pg8::gemm_phase<pg8::EpiResid, pg8::StaticOrder, true, true>(ldsl, g, S, E); }
    GRID_SYNC();
    norm_rows<1>(a.out, a.out + (size_t)NCTX * DM, a.in[33], nullptr, 0, 0, nullptr, a.out, gw, NGW, lane);
}

extern "C" void kernel_launch(void* const* d_in, const int* in_sizes, int n_in, void* d_out, int out_size, void* d_ws, size_t ws_size, hipStream_t stream) {
    static int grid = 0;
    if (grid == 0) {
        if (n_in != 34 || ws_size < WS_END) { fprintf(stderr, "kernel_launch: expected 34 inputs and >= %zu bytes of workspace; got %d, %zu\n", (size_t)WS_END, n_in, ws_size); grid = -1; return; }
        int dev = 0, cus = 0, per_cu = 0;
        (void)hipGetDevice(&dev);
        (void)hipDeviceGetAttribute(&cus, hipDeviceAttributeMultiprocessorCount, dev);
        if (hipFuncSetAttribute((const void*)fwd_megakernel, hipFuncAttributeMaxDynamicSharedMemorySize, LDS_BYTES) != hipSuccess) fprintf(stderr, "kernel_launch: hipFuncSetAttribute failed\n");
        if (hipOccupancyMaxActiveBlocksPerMultiprocessor(&per_cu, (const void*)fwd_megakernel, NTHR, LDS_BYTES) != hipSuccess || per_cu < 1) { fprintf(stderr, "kernel_launch: occupancy query gave %d\n", per_cu); per_cu = 1; }
        (void)hipGetLastError();
        if (cus <= 0) cus = 256;
        grid = cus * (per_cu > 1 ? 1 : per_cu);
        if (grid < 144) fprintf(stderr, "kernel_launch: grid %d < 144\n", grid);
    }
    if (grid < 0) return;
    if (hipMemsetAsync(d_ws, 0, 16384, stream) != hipSuccess) { fprintf(stderr, "kernel_launch: memset failed\n"); return; }
    Args a{};
    for (int i = 0; i < 34; ++i) a.in[i] = (const float*)d_in[i];
    a.out = (float*)d_out; a.ws = (unsigned char*)d_ws;
    void* args[] = {&a};
    hipError_t e = hipLaunchCooperativeKernel((const void*)fwd_megakernel, dim3(grid), dim3(NTHR), args, LDS_BYTES, stream);
    if (e != hipSuccess) fprintf(stderr, "cooperative launch failed: %s (grid %d)\n", hipGetErrorString(e), grid);
}
```
